# Optimizing an MI355X kernel written in HIP

```python
import math
import jax, jax.numpy as jnp
from jax import lax
import numpy as np

D_MODEL = 1024
BATCH = 8
SEQ = 4096
DEPTH = 2

DA_HEADS = 4
DA_HEAD_DIM = 64
DA_WIDTH = DA_HEADS * 2 * DA_HEAD_DIM
MLA_HEADS = 4
MLA_Q_RANK = 256
MLA_KV_RANK = 128
MLA_NOPE_DIM = 64
MLA_ROPE_DIM = 32
MLA_V_DIM = 128
ROPE_THETA = 10000.0
AB_IN_WIDTH = 3 * DA_WIDTH + MLA_Q_RANK + MLA_KV_RANK + MLA_ROPE_DIM
AB_MIX_WIDTH = DA_WIDTH + MLA_HEADS * MLA_V_DIM
DIL_HEADS = 16
DIL_HEAD_DIM = 64
DIL_PATTERNS = ((128, 1), (512, 4), (2048, 16))
DIL_Q_BLOCK = 64
Q_BLOCK = 128
MOE_GROUPS = 4
MOE_EXPERTS_PER_GROUP = 8
MOE_EXPERTS = MOE_GROUPS * MOE_EXPERTS_PER_GROUP
MOE_TOP_K = 2
MOE_HIDDEN = 512
MOE_BLOCK = 256
N_EVEN = (DEPTH + 1) // 2
N_ODD = DEPTH // 2
DEEPNORM_ALPHA = (2 * DEPTH) ** 0.25
DEEPNORM_BETA = (8 * DEPTH) ** -0.25
NORM_EPS = 1e-5

kernel_name = 'hybrid_diff_mla_dilated_hmoe_encoder'


def _layer_norm(x, g, b):
    xf = x.astype(jnp.float32)
    mu = jnp.mean(xf, -1, keepdims=True)
    var = jnp.mean(jnp.square(xf - mu), -1, keepdims=True)
    return ((xf - mu) * lax.rsqrt(var + NORM_EPS)).astype(x.dtype) * g + b


def _rms_norm(x, g):
    xf = x.astype(jnp.float32)
    return (xf * lax.rsqrt(jnp.mean(jnp.square(xf), -1, keepdims=True) + NORM_EPS)).astype(x.dtype) * g


def _alibi_slopes(n_heads):
    start = 2.0 ** (-8.0 / n_heads)
    return jnp.asarray([start ** (i + 1) for i in range(n_heads)], dtype=jnp.float32)


def _rope(t):
    s, r = t.shape[1], t.shape[-1]
    half = r // 2
    inv_freq = jnp.power(ROPE_THETA, -jnp.arange(half, dtype=jnp.float32) * 2.0 / r)
    ang = jnp.arange(s, dtype=jnp.float32)[:, None] * inv_freq[None, :]
    cos = jnp.cos(ang)[None, :, None, :]
    sin = jnp.sin(ang)[None, :, None, :]
    tf = t.astype(jnp.float32)
    t1, t2 = tf[..., :half], tf[..., half:]
    return jnp.concatenate([t1 * cos - t2 * sin, t1 * sin + t2 * cos], -1).astype(t.dtype)


def _to_blocks(t, blk):
    return jnp.swapaxes(t.reshape(t.shape[0], t.shape[1] // blk, blk, *t.shape[2:]), 0, 1)


def _from_blocks(t):
    t = jnp.swapaxes(t, 0, 1)
    return t.reshape(t.shape[0], t.shape[1] * t.shape[2], *t.shape[3:])


def _diff_attention(q1, q2, k1, k2, v, lam, slopes):
    s = q1.shape[1]
    scale = q1.shape[-1] ** -0.5
    pos = jnp.arange(s, dtype=jnp.float32)

    def block(args):
        q1b, q2b, qpos = args
        bias = -slopes[:, None, None] * jnp.abs(qpos[:, None] - pos[None, :])[None]
        s1 = jnp.einsum('bqhd,bkhd->bhqk', q1b, k1).astype(jnp.float32) * scale + bias
        s2 = jnp.einsum('bqhd,bkhd->bhqk', q2b, k2).astype(jnp.float32) * scale + bias
        attn = jax.nn.softmax(s1, -1) - lam * jax.nn.softmax(s2, -1)
        return jnp.einsum('bhqk,bkhe->bqhe', attn.astype(v.dtype), v)

    out = lax.map(block, (_to_blocks(q1, Q_BLOCK), _to_blocks(q2, Q_BLOCK), pos.reshape(s // Q_BLOCK, Q_BLOCK)))
    return _from_blocks(out)


def _mla_attention(q_nope, q_rope, k_nope, k_rope, v):
    scale = (q_nope.shape[-1] + q_rope.shape[-1]) ** -0.5

    def block(args):
        qnb, qrb = args
        sc = (jnp.einsum('bqhd,bkhd->bhqk', qnb, k_nope)
              + jnp.einsum('bqhr,bkr->bhqk', qrb, k_rope)).astype(jnp.float32) * scale
        p = jax.nn.softmax(sc, -1)
        return jnp.einsum('bhqk,bkhe->bqhe', p.astype(v.dtype), v)

    out = lax.map(block, (_to_blocks(q_nope, Q_BLOCK), _to_blocks(q_rope, Q_BLOCK)))
    return _from_blocks(out)


def _dilated_attention(q, k, v, slopes):
    s = q.shape[1]
    scale = q.shape[-1] ** -0.5

    def block(args):
        qb, t0 = args
        t = t0 + jnp.arange(DIL_Q_BLOCK, dtype=jnp.int32)
        outs, lses = [], []
        for window, dilation in DIL_PATTERNS:
            n_side = window // (2 * dilation)
            off = dilation * (jnp.arange(2 * n_side + 1, dtype=jnp.int32) - n_side)
            idx = t[:, None] + off[None, :]
            valid = (idx >= 0) & (idx < s)
            idx = jnp.clip(idx, 0, s - 1)
            kg = k[:, idx]
            vg = v[:, idx]
            sc = jnp.einsum('bqhd,bqjhd->bhqj', qb, kg).astype(jnp.float32) * scale
            sc = sc - slopes[:, None, None] * jnp.abs(off).astype(jnp.float32)
            sc = jnp.where(valid, sc, -jnp.inf)
            lse = jax.nn.logsumexp(sc, -1)
            p = jnp.exp(sc - lse[..., None])
            outs.append(jnp.einsum('bhqj,bqjhd->bqhd', p.astype(v.dtype), vg))
            lses.append(lse)
        mix = jax.nn.softmax(jnp.stack(lses), axis=0)
        mix = jnp.swapaxes(mix, 2, 3)[..., None].astype(v.dtype)
        return sum(mix[i] * o for i, o in enumerate(outs))

    starts = jnp.arange(s // DIL_Q_BLOCK, dtype=jnp.int32) * DIL_Q_BLOCK
    out = lax.map(block, (_to_blocks(q, DIL_Q_BLOCK), starts))
    return _from_blocks(out)


def _mixer_ab(x, w_in, lam_q1, lam_k1, lam_q2, lam_k2, diff_g, q_norm_g, w_uq, kv_norm_g, w_ukv, w_out, layer_idx):
    b, s, _ = x.shape
    h = x @ w_in
    cuts = [DA_WIDTH, 2 * DA_WIDTH, 3 * DA_WIDTH, 3 * DA_WIDTH + MLA_Q_RANK, 3 * DA_WIDTH + MLA_Q_RANK + MLA_KV_RANK]
    qa, ka, va, c_q, c_kv, k_r = jnp.split(h, cuts, axis=-1)
    qa = qa.reshape(b, s, DA_HEADS, 2, DA_HEAD_DIM)
    ka = ka.reshape(b, s, DA_HEADS, 2, DA_HEAD_DIM)
    va = va.reshape(b, s, DA_HEADS, 2 * DA_HEAD_DIM)
    lam_init = 0.8 - 0.6 * math.exp(-0.3 * layer_idx)
    lam = (jnp.exp(jnp.sum(lam_q1 * lam_k1).astype(jnp.float32))
           - jnp.exp(jnp.sum(lam_q2 * lam_k2).astype(jnp.float32)) + lam_init)
    oa = _diff_attention(qa[:, :, :, 0], qa[:, :, :, 1], ka[:, :, :, 0], ka[:, :, :, 1], va, lam,
                         _alibi_slopes(DA_HEADS))
    oa = _rms_norm(oa, diff_g) * (1.0 - lam_init)
    q = (_rms_norm(c_q, q_norm_g) @ w_uq).reshape(b, s, MLA_HEADS, MLA_NOPE_DIM + MLA_ROPE_DIM)
    q_nope, q_rope = q[..., :MLA_NOPE_DIM], _rope(q[..., MLA_NOPE_DIM:])
    kv = (_rms_norm(c_kv, kv_norm_g) @ w_ukv).reshape(b, s, MLA_HEADS, MLA_NOPE_DIM + MLA_V_DIM)
    k_nope, vb = kv[..., :MLA_NOPE_DIM], kv[..., MLA_NOPE_DIM:]
    k_rope = _rope(k_r[:, :, None, :])[:, :, 0]
    ob = _mla_attention(q_nope, q_rope, k_nope, k_rope, vb)
    o = jnp.concatenate([oa.reshape(b, s, -1), ob.reshape(b, s, -1)], -1)
    return o @ w_out


def _mixer_c(x, w_in, w_out):
    b, s, _ = x.shape
    h = (x @ w_in).reshape(b, s, 3, DIL_HEADS, DIL_HEAD_DIM)
    o = _dilated_attention(h[:, :, 0], h[:, :, 1], h[:, :, 2], _alibi_slopes(DIL_HEADS))
    return o.reshape(b, s, -1) @ w_out


def _hier_moe(x, w_group, b_group, w_route, b_route, w_gate, w_up, w_down):
    b, s, d = x.shape
    n_tok = b * s
    xf = x.reshape(n_tok, d)
    coarse = (xf @ w_group + b_group).astype(jnp.float32)
    g_sel = jnp.argmax(coarse, -1)
    p_group = jnp.take_along_axis(jax.nn.softmax(coarse, -1), g_sel[:, None], -1)[:, 0]
    fine = (xf @ w_route + b_route).astype(jnp.float32).reshape(n_tok, MOE_GROUPS, MOE_EXPERTS_PER_GROUP)
    fine = jnp.take_along_axis(fine, g_sel[:, None, None], axis=1)[:, 0]
    top_v, top_i = lax.top_k(fine, MOE_TOP_K)
    gate = (p_group[:, None] * jax.nn.softmax(top_v, -1)).astype(x.dtype)
    eid = g_sel[:, None].astype(jnp.int32) * MOE_EXPERTS_PER_GROUP + top_i.astype(jnp.int32)
    n_asg = n_tok * MOE_TOP_K
    a_eid = eid.reshape(-1)
    a_tok = jnp.repeat(jnp.arange(n_tok, dtype=jnp.int32), MOE_TOP_K)
    a_w = gate.reshape(-1)
    order = jnp.argsort(a_eid)
    s_eid, s_tok, s_w = a_eid[order], a_tok[order], a_w[order]
    counts = jnp.bincount(a_eid, length=MOE_EXPERTS).astype(jnp.int32)
    padded = (counts + MOE_BLOCK - 1) // MOE_BLOCK * MOE_BLOCK
    raw_start = jnp.cumsum(counts) - counts
    pad_end = jnp.cumsum(padded)
    pad_start = pad_end - padded
    n_slot = n_asg + MOE_EXPERTS * MOE_BLOCK
    n_blk = n_slot // MOE_BLOCK
    dest = pad_start[s_eid] + jnp.arange(n_asg, dtype=jnp.int32) - raw_start[s_eid]
    slot_tok = jnp.full((n_slot,), n_tok, jnp.int32).at[dest].set(s_tok)
    slot_w = jnp.zeros((n_slot,), x.dtype).at[dest].set(s_w)
    blk_eid = jnp.minimum(jnp.searchsorted(pad_end, jnp.arange(n_blk, dtype=jnp.int32) * MOE_BLOCK, side='right'),
                          MOE_EXPERTS - 1)
    x_pad = jnp.concatenate([xf, jnp.zeros((1, d), xf.dtype)], 0)

    def expert_block(args):
        e, tok = args
        xb = x_pad[tok]
        hb = jax.nn.silu(xb @ w_gate[e]) * (xb @ w_up[e])
        return hb @ w_down[e]

    ys = lax.map(expert_block, (blk_eid, slot_tok.reshape(n_blk, MOE_BLOCK)))
    ys = ys.reshape(n_slot, d) * slot_w[:, None]
    out = jnp.zeros((n_tok + 1, d), x.dtype).at[slot_tok].add(ys)[:n_tok]
    return out.reshape(b, s, d)


def setup_inputs(seed: int = 0) -> dict:
    key = jax.random.key(seed)
    ks = iter(jax.random.split(key, 32))

    def nrm(shape, scale):
        return jax.random.normal(next(ks), shape, jnp.float32) * scale

    def gain(shape):
        return 1.0 + nrm(shape, 0.02)

    d = D_MODEL
    dil_w = DIL_HEADS * DIL_HEAD_DIM
    return {
        'x': nrm((BATCH, SEQ, d), 1.0),
        'w_in_ab': nrm((N_EVEN, d, AB_IN_WIDTH), d ** -0.5),
        'lam_q1': nrm((N_EVEN, DA_HEAD_DIM), 0.1),
        'lam_k1': nrm((N_EVEN, DA_HEAD_DIM), 0.1),
        'lam_q2': nrm((N_EVEN, DA_HEAD_DIM), 0.1),
        'lam_k2': nrm((N_EVEN, DA_HEAD_DIM), 0.1),
        'diff_norm_g': gain((N_EVEN, 2 * DA_HEAD_DIM)),
        'mla_q_norm_g': gain((N_EVEN, MLA_Q_RANK)),
        'w_uq': nrm((N_EVEN, MLA_Q_RANK, MLA_HEADS * (MLA_NOPE_DIM + MLA_ROPE_DIM)), MLA_Q_RANK ** -0.5),
        'mla_kv_norm_g': gain((N_EVEN, MLA_KV_RANK)),
        'w_ukv': nrm((N_EVEN, MLA_KV_RANK, MLA_HEADS * (MLA_NOPE_DIM + MLA_V_DIM)), MLA_KV_RANK ** -0.5),
        'w_out_ab': nrm((N_EVEN, AB_MIX_WIDTH, d), AB_MIX_WIDTH ** -0.5 * DEEPNORM_BETA),
        'w_in_c': nrm((N_ODD, d, 3 * dil_w), d ** -0.5),
        'w_out_c': nrm((N_ODD, dil_w, d), dil_w ** -0.5 * DEEPNORM_BETA),
        'ln_mix_g': gain((DEPTH, d)),
        'ln_mix_b': nrm((DEPTH, d), 0.02),
        'moe_w_group': nrm((DEPTH, d, MOE_GROUPS), d ** -0.5),
        'moe_b_group': nrm((DEPTH, MOE_GROUPS), 0.01),
        'moe_w_route': nrm((DEPTH, d, MOE_EXPERTS), d ** -0.5),
        'moe_b_route': nrm((DEPTH, MOE_EXPERTS), 0.01),
        'moe_w_gate': nrm((DEPTH, MOE_EXPERTS, d, MOE_HIDDEN), d ** -0.5),
        'moe_w_up': nrm((DEPTH, MOE_EXPERTS, d, MOE_HIDDEN), d ** -0.5),
        'moe_w_down': nrm((DEPTH, MOE_EXPERTS, MOE_HIDDEN, d), MOE_HIDDEN ** -0.5 * DEEPNORM_BETA),
        'ln_ffn_g': gain((DEPTH, d)),
        'ln_ffn_b': nrm((DEPTH, d), 0.02),
    }


def reference(x, w_in_ab, lam_q1, lam_k1, lam_q2, lam_k2, diff_norm_g, mla_q_norm_g, w_uq, mla_kv_norm_g, w_ukv,
              w_out_ab, w_in_c, w_out_c, ln_mix_g, ln_mix_b, moe_w_group, moe_b_group, moe_w_route, moe_b_route,
              moe_w_gate, moe_w_up, moe_w_down, ln_ffn_g, ln_ffn_b):
    for layer in range(DEPTH):
        i = layer // 2
        if layer % 2 == 0:
            mixed = _mixer_ab(x, w_in_ab[i], lam_q1[i], lam_k1[i], lam_q2[i], lam_k2[i], diff_norm_g[i],
                              mla_q_norm_g[i], w_uq[i], mla_kv_norm_g[i], w_ukv[i], w_out_ab[i], layer)
        else:
            mixed = _mixer_c(x, w_in_c[i], w_out_c[i])
        x = _layer_norm(DEEPNORM_ALPHA * x + mixed, ln_mix_g[layer], ln_mix_b[layer])
        ffn = _hier_moe(x, moe_w_group[layer], moe_b_group[layer], moe_w_route[layer], moe_b_route[layer],
                        moe_w_gate[layer], moe_w_up[layer], moe_w_down[layer])
        x = _layer_norm(DEEPNORM_ALPHA * x + ffn, ln_ffn_g[layer], ln_ffn_b[layer])
    return x
```

```cpp
#include <hip/hip_runtime.h>
#include <hip/hip_cooperative_groups.h>
#include <cstdio>
#include <cstdint>
namespace cg = cooperative_groups;

constexpr int D_MODEL = 1024, BATCH = 8, SEQ = 4096, T = BATCH * SEQ;
constexpr int AB_IN = 1952, H0_LD = 2048, VT_LD = T + 64;
constexpr int MOE_E = 32, MOE_H = 512;
constexpr float ALPHA = 1.4142135623730951f;
constexpr float EPS = 1e-5f;
constexpr int NTHREADS = 512;
#ifndef PROBE
#define PROBE 0
#endif

typedef unsigned short bf16_t;

constexpr size_t MiB = 1ull << 20;
constexpr size_t WS_CTL = 0;
constexpr size_t WS_LTOK = 1 * MiB;
constexpr size_t WS_LW = 5 * MiB;
constexpr size_t WS_EPOS = 9 * MiB;
constexpr size_t WS_RS = 9 * MiB + 256 * 1024;
constexpr size_t WS_RTAB = 9 * MiB + 512 * 1024;
constexpr size_t WS_RCONST = WS_RTAB + 320 * 1024;
constexpr size_t WS_WSMALL = 10 * MiB;
constexpr size_t WT_IN_AB = WS_WSMALL;
constexpr size_t WT_UQ = WT_IN_AB + 4 * MiB;
constexpr size_t WT_UKV = WT_UQ + 256 * 1024;
constexpr size_t WT_OUT_AB = WT_UKV + 256 * 1024;
constexpr size_t WT_IN_C = WT_OUT_AB + 2 * MiB;
constexpr size_t WT_OUT_C = WT_IN_C + 6 * MiB;
constexpr size_t WS_XB = 26 * MiB;
constexpr size_t WS_HBUF = 90 * MiB;
constexpr size_t WS_Q = 282 * MiB;
constexpr size_t WS_END = 491 * MiB;
constexpr size_t HB_YB = 0;
constexpr size_t HB_H = 0;
constexpr size_t HB_Y = 64 * MiB;
constexpr size_t Q_QB = 0;
constexpr size_t Q_KB = 24 * MiB;
constexpr size_t Q_VB = 48 * MiB;
constexpr size_t Q_AO = 80 * MiB;
constexpr size_t Q_VTA = 176 * MiB;
constexpr size_t Q_OPART = 64 * MiB;
constexpr size_t Q_LSE = 192 * MiB;
constexpr size_t HB_AOC = 128 * MiB;
constexpr size_t Q_O1 = 0;
constexpr int CW_CNT = 1024;

struct Params {
    const float* in[25];
    float* out;
    unsigned char* ws;
};

__device__ __forceinline__ bf16_t f2bf(float f) { unsigned u = __float_as_uint(f); u += 0x7fffu + ((u >> 16) & 1u); return (bf16_t)(u >> 16); }
__device__ __forceinline__ float bf2f(bf16_t h) { return __uint_as_float(((unsigned)h) << 16); }
__device__ __forceinline__ float wave_sum(float v) {
#pragma unroll
    for (int o = 1; o < 64; o <<= 1) v += __shfl_xor(v, o);
    return v;
}

__device__ __forceinline__ int thr() { int t = threadIdx.x; asm volatile("" : "+v"(t)); return t; }
__device__ __forceinline__ int xcd_item(int k) { const int G = gridDim.x, bid = blockIdx.x; if (G & 7) return bid + k * G; const int J = G >> 3; return (k * 8 + (bid & 7)) * J + (bid >> 3); }
typedef short bf16x8 __attribute__((ext_vector_type(8)));
typedef float f32x16 __attribute__((ext_vector_type(16)));
typedef unsigned u32x4 __attribute__((ext_vector_type(4)));
typedef __bf16 bf16x2_t __attribute__((ext_vector_type(2)));
typedef float f32x2_t __attribute__((ext_vector_type(2)));
__device__ __forceinline__ unsigned pk2(float lo, float hi) { f32x2_t v = {lo, hi}; return __builtin_bit_cast(unsigned, __builtin_convertvector(v, bf16x2_t)); }
#define MFMA32(a, b, c) __builtin_amdgcn_mfma_f32_32x32x16_bf16((a), (b), (c), 0, 0, 0)
__device__ __forceinline__ void unpack8(const u32x4& v, float (&f)[8]) {
    f[0] = __uint_as_float(v.x << 16); f[1] = __uint_as_float(v.x & 0xffff0000u); f[2] = __uint_as_float(v.y << 16); f[3] = __uint_as_float(v.y & 0xffff0000u);
    f[4] = __uint_as_float(v.z << 16); f[5] = __uint_as_float(v.z & 0xffff0000u); f[6] = __uint_as_float(v.w << 16); f[7] = __uint_as_float(v.w & 0xffff0000u);
}

__device__ __forceinline__ int swz128(int row, int chunk) { return row * 128 + ((chunk ^ ((row >> 1) & 7)) << 4); }
namespace g8 {
#define G8_LAS __attribute__((address_space(3)))
typedef float f32x4 __attribute__((ext_vector_type(4)));
constexpr int BM = 256, BK = 64, HALF = 128, HTB = HALF * BK * 2, RING = 8 * HTB;
__device__ __forceinline__ int lds_byte(int r, int c) { const int st = (r >> 4) * 2 + (c >> 5), rr = r & 15, cc = c & 31, ob = rr * 64 + cc * 2; return st * 1024 + (ob ^ (((ob >> 9) & 1) << 5)); }
__device__ __forceinline__ void stage_rc(int b, int& R, int& C) { const int st = b / 1024, sb = b % 1024, swz = sb ^ (((sb >> 9) & 1) << 5); R = (st >> 1) * 16 + swz / 64; C = (st & 1) * 32 + (swz % 64) / 2; }
__device__ __forceinline__ int perm32(int rho) { const int n = rho >> 4, i = rho & 15; return 8 * (i >> 2) + 4 * n + (i & 3); }
struct Unit { const char* a; const char* b; int r0, c0, x0, x1, x2, x3; };

template <class Epi, class Sched>
__device__ __forceinline__ void gemm_phase(G8_LAS unsigned char* lds, int K, int ldb, const Sched& S, const Epi& E) {
    const int tid = thr(), wid = __builtin_amdgcn_readfirstlane(tid >> 6), lane = tid & 63, wr = wid >> 2, wc = wid & 3, fr = lane & 15, fq = lane >> 4;
    asm volatile("" : "+s"(K));
    const int nt = K / BK;
    int Rr[2], Cc[2]; unsigned voffB[2];
#pragma unroll
    for (int i = 0; i < 2; ++i) { stage_rc(tid * 16 + i * 8192, Rr[i], Cc[i]); const int Rb = (Rr[i] & ~31) + perm32(Rr[i] & 31); voffB[i] = (unsigned)(Rb * ldb + Cc[i]) * 2u; }
    const size_t kstep = (size_t)(BK * 2);
    const size_t hstepB = (size_t)HALF * ldb * 2;
    const unsigned ldsw = (unsigned)wid * 1024u;
    const int aoff = lds_byte(wr * 64 + fr, fq * 8), boff = lds_byte(wc * 32 + fr, fq * 8);
#define G8_SA(b, h) (((b) * 2 + (h)) * HTB)
#define G8_SB(b, h) ((4 + (b) * 2 + (h)) * HTB)
#define G8_STAGE_B(bufoff, gbase) do { _Pragma("unroll") for (int _i = 0; _i < 2; ++_i) \
        __builtin_amdgcn_global_load_lds((const unsigned*)((const char*)(gbase) + voffB[_i]), (G8_LAS unsigned*)(lds + (bufoff) + ldsw + _i * 8192), 16, 0, 0); } while (0)
#define G8_STAGE_A(bufoff, gbase, offs) do { _Pragma("unroll") for (int _i = 0; _i < 2; ++_i) \
        __builtin_amdgcn_global_load_lds((const unsigned*)((const char*)(gbase) + (offs)[_i]), (G8_LAS unsigned*)(lds + (bufoff) + ldsw + _i * 8192), 16, 0, 0); } while (0)
#define G8_LDA(dst, b, h) do { _Pragma("unroll") for (int m = 0; m < 4; ++m) _Pragma("unroll") for (int k = 0; k < 2; ++k) dst[m][k] = *(const G8_LAS bf16x8*)(lds + G8_SA(b, h) + aoff + m * 2048 + k * 1024); } while (0)
#define G8_LDB(dst, b, h) do { _Pragma("unroll") for (int n = 0; n < 2; ++n) _Pragma("unroll") for (int k = 0; k < 2; ++k) dst[n][k] = *(const G8_LAS bf16x8*)(lds + G8_SB(b, h) + boff + n * 2048 + k * 1024); } while (0)
#define G8_MMA(ai, bj, At, Bt) do { __builtin_amdgcn_s_setprio(1); _Pragma("unroll") for (int m = 0; m < 4; ++m) _Pragma("unroll") for (int n = 0; n < 2; ++n) _Pragma("unroll") for (int k = 0; k < 2; ++k) \
        acc[ai][bj][m][n] = __builtin_amdgcn_mfma_f32_16x16x32_bf16(Bt[n][k], At[m][k], acc[ai][bj][m][n], 0, 0, 0); __builtin_amdgcn_s_setprio(0); } while (0)
#define G8_WAIT_V(n) asm volatile("s_waitcnt vmcnt(" #n ")" ::: "memory")
#define G8_WAIT_L(n) asm volatile("s_waitcnt lgkmcnt(" #n ")" ::: "memory")
#define G8_BAR __builtin_amdgcn_s_barrier()
#define G8_SCHED __builtin_amdgcn_sched_barrier(0)
    Unit cur, nxt; int ui = 0;
    if (!S.next(0, cur)) return;
    f32x4 acc[2][2][4][2];
#pragma unroll
    for (int a = 0; a < 2; ++a)
#pragma unroll
        for (int b = 0; b < 2; ++b)
#pragma unroll
            for (int m = 0; m < 4; ++m)
#pragma unroll
                for (int n = 0; n < 2; ++n) acc[a][b][m][n] = (f32x4){0.f, 0.f, 0.f, 0.f};
    bf16x8 At[4][2], B0[2][2], B1[2][2];
    unsigned ac[2][2], an[2][2];
#pragma unroll
    for (int h = 0; h < 2; ++h)
#pragma unroll
        for (int i = 0; i < 2; ++i) ac[h][i] = S.a_off(cur, 128 * h + Rr[i]) + (unsigned)Cc[i] * 2u;
    const char* cA = cur.a; const char* cB = cur.b;
    G8_BAR;
    G8_STAGE_B(G8_SB(0, 0), cB); G8_STAGE_B(G8_SB(0, 1), cB + hstepB); G8_STAGE_A(G8_SA(0, 0), cA, ac[0]); G8_STAGE_A(G8_SA(0, 1), cA, ac[1]);
    if (wr == 1) G8_BAR;
    G8_WAIT_V(2); G8_BAR;
    G8_STAGE_B(G8_SB(1, 0), cB + kstep); G8_STAGE_A(G8_SA(1, 0), cA + kstep, ac[0]); G8_STAGE_B(G8_SB(1, 1), cB + hstepB + kstep);
    G8_WAIT_V(6); G8_BAR;
    for (;;) {
        const bool has_next = S.next(ui + 1, nxt);
        const char* nA = has_next ? nxt.a : cA; const char* nB = has_next ? nxt.b : cB;
#pragma unroll
        for (int h = 0; h < 2; ++h)
#pragma unroll
            for (int i = 0; i < 2; ++i) an[h][i] = has_next ? S.a_off(nxt, 128 * h + Rr[i]) + (unsigned)Cc[i] * 2u : ac[h][i];
#pragma unroll 1
        for (int t = 0; t < nt; t += 2) {
            const bool last = (t == nt - 2);
            const char* a1 = cA + (size_t)(t + 1) * kstep;
            const char* a2 = last ? nA : cA + (size_t)(t + 2) * kstep; const char* b2 = last ? nB : cB + (size_t)(t + 2) * kstep;
            const char* a3 = a2 + kstep; const char* b3 = b2 + kstep;
            unsigned a2o[2][2];
#pragma unroll
            for (int h = 0; h < 2; ++h)
#pragma unroll
                for (int i = 0; i < 2; ++i) a2o[h][i] = last ? an[h][i] : ac[h][i];
            G8_LDB(B0, 0, 0); G8_LDB(B1, 0, 1); G8_SCHED; G8_LDA(At, 0, 0); G8_STAGE_A(G8_SA(1, 1), a1, ac[1]);
            G8_WAIT_V(8); G8_WAIT_L(0); G8_BAR; G8_MMA(0, 0, At, B0); G8_MMA(0, 1, At, B1); G8_BAR; G8_SCHED;
            G8_LDA(At, 0, 1); G8_STAGE_B(G8_SB(0, 0), b2); G8_STAGE_B(G8_SB(0, 1), b2 + hstepB); G8_STAGE_A(G8_SA(0, 0), a2, a2o[0]);
            G8_WAIT_V(8); G8_WAIT_L(0); G8_BAR; G8_MMA(1, 0, At, B0); G8_MMA(1, 1, At, B1); G8_BAR; G8_SCHED;
            G8_LDB(B0, 1, 0); G8_LDB(B1, 1, 1); G8_SCHED; G8_LDA(At, 1, 0); G8_STAGE_A(G8_SA(0, 1), a2, a2o[1]);
            G8_WAIT_V(8); G8_WAIT_L(0); G8_BAR; G8_MMA(0, 0, At, B0); G8_MMA(0, 1, At, B1); G8_BAR; G8_SCHED;
            G8_LDA(At, 1, 1); G8_STAGE_B(G8_SB(1, 0), b3); G8_STAGE_B(G8_SB(1, 1), b3 + hstepB); G8_STAGE_A(G8_SA(1, 0), a3, a2o[0]);
            G8_WAIT_V(8); G8_WAIT_L(0); G8_BAR; G8_MMA(1, 0, At, B0); G8_MMA(1, 1, At, B1); G8_BAR; G8_SCHED;
        }
        if (wr == 0) G8_BAR;
        E(acc, cur, wr, wc, fr, fq);
        if (!has_next) break;
#pragma unroll
        for (int a = 0; a < 2; ++a)
#pragma unroll
            for (int b = 0; b < 2; ++b)
#pragma unroll
                for (int m = 0; m < 4; ++m)
#pragma unroll
                    for (int n = 0; n < 2; ++n) acc[a][b][m][n] = (f32x4){0.f, 0.f, 0.f, 0.f};
        cur = nxt; cA = nA; cB = nB; ++ui;
#pragma unroll
        for (int h = 0; h < 2; ++h)
#pragma unroll
            for (int i = 0; i < 2; ++i) ac[h][i] = an[h][i];
        if (wr == 1) G8_BAR;
    }
    G8_WAIT_V(0);
    G8_BAR;
#undef G8_SA
#undef G8_SB
#undef G8_STAGE_A
#undef G8_STAGE_B
#undef G8_LDA
#undef G8_LDB
#undef G8_MMA
#undef G8_WAIT_V
#undef G8_WAIT_L
#undef G8_BAR
#undef G8_SCHED
}
}

struct SchedDense {
    const char* A; const char* B; int lda2, ldb2, nN, nunits, skip_lo, skip_hi;
    __device__ __forceinline__ bool next(int i, g8::Unit& u) const {
        const int L = xcd_item(i); if (L >= nunits) return false;
        const int nNe = nN - (skip_hi - skip_lo), pm = L / nNe; int pn = L % nNe; if (pn >= skip_lo) pn += skip_hi - skip_lo;
        u.a = A + (size_t)pm * 256 * lda2; u.b = B + (size_t)pn * 256 * ldb2; u.r0 = pm * 256; u.c0 = pn * 256; u.x0 = 0; u.x1 = 0; u.x2 = 0; u.x3 = 0; return true;
    }
    __device__ __forceinline__ unsigned a_off(const g8::Unit&, int row) const { return (unsigned)row * (unsigned)lda2; }
};
struct EpiRowBf16 {
    bf16_t* O; int ld, N;
    __device__ __forceinline__ void operator()(const g8::f32x4 (&acc)[2][2][4][2], const g8::Unit& u, int wr, int wc, int fr, int fq) const {
#pragma unroll
        for (int ai = 0; ai < 2; ++ai)
#pragma unroll
            for (int m = 0; m < 4; ++m) {
                bf16_t* rowp = O + (size_t)(u.r0 + 128 * ai + 64 * wr + 16 * m + fr) * ld + u.c0 + 32 * wc + 8 * fq;
#pragma unroll
                for (int bj = 0; bj < 2; ++bj) {
                    if (u.c0 + 128 * bj + 32 * wc + 8 * fq < N) {
                        const g8::f32x4 v0 = acc[ai][bj][m][0], v1 = acc[ai][bj][m][1];
                        u32x4 w; w.x = pk2(v0[0], v0[1]); w.y = pk2(v0[2], v0[3]); w.z = pk2(v1[0], v1[1]); w.w = pk2(v1[2], v1[3]);
                        *(u32x4*)(rowp + 128 * bj) = w;
                    }
                }
            }
    }
};

template <bool SRC_F32>
struct EpiResidualBf16 {
    const void* src; bf16_t* dst;
    __device__ __forceinline__ void operator()(const g8::f32x4 (&acc)[2][2][4][2], const g8::Unit& u, int wr, int wc, int fr, int fq) const {
#pragma unroll
        for (int ai = 0; ai < 2; ++ai)
#pragma unroll
            for (int m = 0; m < 4; ++m) {
                const size_t ro = (size_t)(u.r0 + 128 * ai + 64 * wr + 16 * m + fr) * D_MODEL + u.c0 + 32 * wc + 8 * fq;
#pragma unroll
                for (int bj = 0; bj < 2; ++bj) {
                    float r[8];
                    if (SRC_F32) {
                        const float4 a = *(const float4*)((const float*)src + ro + 128 * bj), b = *(const float4*)((const float*)src + ro + 128 * bj + 4);
                        r[0] = a.x; r[1] = a.y; r[2] = a.z; r[3] = a.w; r[4] = b.x; r[5] = b.y; r[6] = b.z; r[7] = b.w;
                    } else unpack8(*(const u32x4*)((const bf16_t*)src + ro + 128 * bj), r);
                    const g8::f32x4 v0 = acc[ai][bj][m][0], v1 = acc[ai][bj][m][1];
                    u32x4 w;
                    w.x = pk2(ALPHA * r[0] + v0[0], ALPHA * r[1] + v0[1]); w.y = pk2(ALPHA * r[2] + v0[2], ALPHA * r[3] + v0[3]);
                    w.z = pk2(ALPHA * r[4] + v1[0], ALPHA * r[5] + v1[1]); w.w = pk2(ALPHA * r[6] + v1[2], ALPHA * r[7] + v1[3]);
                    *(u32x4*)(dst + ro + 128 * bj) = w;
                }
            }
    }
};


template <bool UP>
struct SchedMoe {
    const char* A; const char* B; int ldb2; size_t bstride; const int* sbase; const int* stile; const int* ltok;
    __device__ __forceinline__ bool next(int i, g8::Unit& u) const {
        const int L = xcd_item(i), tile = L >> 2, pn = L & 3;
        if (tile >= stile[32]) return false;
        int e = 0;
        while (e < 31 && stile[e + 1] <= tile) ++e;
        const int tr0 = (tile - stile[e]) * 256, cnt = sbase[e + 1] - sbase[e];
        u.b = B + (size_t)e * bstride + (size_t)pn * 256 * ldb2;
        u.r0 = sbase[e] + tr0; u.c0 = pn * 256; u.x0 = e; u.x1 = min(256, cnt - tr0); u.x2 = tr0; u.x3 = cnt;
        u.a = UP ? A : A + (size_t)u.r0 * (MOE_H * 2);
        return true;
    }
    __device__ __forceinline__ unsigned a_off(const g8::Unit& u, int row) const {
        if (UP) return (unsigned)ltok[(size_t)u.x0 * T + min(u.x2 + row, u.x3 - 1)] * (unsigned)(D_MODEL * 2);
        return (unsigned)row * (unsigned)(MOE_H * 2);
    }
};
struct EpiMoeUp {
    bf16_t* H;
    __device__ __forceinline__ void operator()(const g8::f32x4 (&acc)[2][2][4][2], const g8::Unit& u, int wr, int wc, int fr, int fq) const {
#pragma unroll
        for (int ai = 0; ai < 2; ++ai)
#pragma unroll
            for (int m = 0; m < 4; ++m) {
                const int row = 128 * ai + 64 * wr + 16 * m + fr;
                if (row < u.x1) {
                    float hv[8];
#pragma unroll
                    for (int n = 0; n < 2; ++n)
#pragma unroll
                        for (int e = 0; e < 4; ++e) { const float g = acc[ai][0][m][n][e]; hv[4 * n + e] = g / (1.f + __expf(-g)) * acc[ai][1][m][n][e]; }
                    u32x4 w; w.x = pk2(hv[0], hv[1]); w.y = pk2(hv[2], hv[3]); w.z = pk2(hv[4], hv[5]); w.w = pk2(hv[6], hv[7]);
                    *(u32x4*)(H + (size_t)(u.r0 + row) * MOE_H + (u.c0 >> 1) + 32 * wc + 8 * fq) = w;
                }
            }
    }
};
struct EpiMoeDown {
    bf16_t* Y; const float* lw;
    __device__ __forceinline__ void operator()(const g8::f32x4 (&acc)[2][2][4][2], const g8::Unit& u, int wr, int wc, int fr, int fq) const {
#pragma unroll
        for (int ai = 0; ai < 2; ++ai) {
            const float* lwp = lw + (size_t)u.x0 * T + u.x2;
            float wg4[4];
#pragma unroll
            for (int m = 0; m < 4; ++m) wg4[m] = lwp[min(128 * ai + 64 * wr + 16 * m + fr, u.x1 - 1)];
            asm volatile("" : "+v"(wg4[0]), "+v"(wg4[1]), "+v"(wg4[2]), "+v"(wg4[3]));
#pragma unroll
            for (int m = 0; m < 4; ++m) {
                const int row = 128 * ai + 64 * wr + 16 * m + fr;
                if (row < u.x1) {
                    const float wgt = wg4[m];
                    bf16_t* rowp = Y + (size_t)(u.r0 + row) * D_MODEL + u.c0 + 32 * wc + 8 * fq;
#pragma unroll
                    for (int bj = 0; bj < 2; ++bj) {
                        const g8::f32x4 v0 = acc[ai][bj][m][0], v1 = acc[ai][bj][m][1];
                        u32x4 w; w.x = pk2(v0[0] * wgt, v0[1] * wgt); w.y = pk2(v0[2] * wgt, v0[3] * wgt); w.z = pk2(v1[0] * wgt, v1[1] * wgt); w.w = pk2(v1[2] * wgt, v1[3] * wgt);
                        *(u32x4*)(rowp + 128 * bj) = w;
                    }
                }
            }
        }
    }
};

template <class RM, class KS>
__device__ __forceinline__ void cvt_w_tile(const float* __restrict__ W, int K, int N, int ntn, bf16_t* Wt, int tile, RM rowmap, KS kscale, bf16_t* sT) {
    const int tid = thr();
    const int tk = tile / ntn, tn = tile % ntn, k0 = tk * 64, n0 = tn * 64;
    __syncthreads();
#pragma unroll
    for (int it = 0; it < 2; ++it) {
        const int kk = (tid >> 4) + 32 * it, n4 = (tid & 15) * 4;
        float4 v = make_float4(0.f, 0.f, 0.f, 0.f);
        if (n0 + n4 < N) v = *(const float4*)(W + (size_t)(k0 + kk) * N + n0 + n4);
        const float sc = kscale(k0 + kk);
        sT[(n4 + 0) * 72 + kk] = f2bf(v.x * sc); sT[(n4 + 1) * 72 + kk] = f2bf(v.y * sc);
        sT[(n4 + 2) * 72 + kk] = f2bf(v.z * sc); sT[(n4 + 3) * 72 + kk] = f2bf(v.w * sc);
    }
    __syncthreads();
    const int n = tid >> 3, kq = (tid & 7) * 8;
    const u32x4 a = *(const u32x4*)(sT + n * 72 + kq);
    *(u32x4*)(Wt + (size_t)rowmap(n0 + n) * K + k0 + kq) = a;
}

__device__ __forceinline__ void ph_cvt_x(const Params& p) {
    const float4* x = (const float4*)p.in[0];
    uint2* xb = (uint2*)(p.ws + WS_XB);
    const size_t n4 = (size_t)T * D_MODEL / 4;
    for (size_t i = (size_t)blockIdx.x * NTHREADS + thr(); i < n4; i += (size_t)gridDim.x * NTHREADS) {
        const float4 v = x[i];
        uint2 o; o.x = f2bf(v.x) | ((unsigned)f2bf(v.y) << 16); o.y = f2bf(v.z) | ((unsigned)f2bf(v.w) << 16);
        xb[i] = o;
    }
}

__device__ const float ROPE_INV[16] = {1.000000000e+00f, 5.623413324e-01f, 3.162277639e-01f, 1.778279394e-01f, 1.000000015e-01f, 5.623413250e-02f, 3.162277490e-02f, 1.778279431e-02f,
                                       9.999999776e-03f, 5.623413250e-03f, 3.162277630e-03f, 1.778279431e-03f, 1.000000047e-03f, 5.623413017e-04f, 3.162277571e-04f, 1.778279402e-04f};
__device__ __forceinline__ void rope_cs(int s, int i, float& c, float& sn) {
    const float ang = (float)s * ROPE_INV[i];
    const double rev = (double)ang * 0.15915494309189535;
    const float fr = (float)(rev - __builtin_rint(rev));
    c = __builtin_amdgcn_cosf(fr); sn = __builtin_amdgcn_sinf(fr);
}
__device__ __forceinline__ void moe_prefix(const Params& p, int layer, int* sbase, int* stile) {
    __syncthreads();
    if (thr() == 0) {
        const unsigned* cnt = (const unsigned*)(p.ws + WS_CTL) + CW_CNT + layer * 32;
        int b = 0, tl = 0;
        for (int e = 0; e < 32; ++e) { const int c = (int)__hip_atomic_load(cnt + e, __ATOMIC_RELAXED, __HIP_MEMORY_SCOPE_AGENT); sbase[e] = b; stile[e] = tl; b += c; tl += (c + 255) / 256; }
        sbase[32] = b; stile[32] = tl;
    }
    __syncthreads();
}
__device__ __forceinline__ void ph_ffn_ln(const Params& p, int layer, float* smem, bool final_layer) {
    const float* g = p.in[23] + layer * D_MODEL; const float* bta = p.in[24] + layer * D_MODEL;
    const bf16_t* Y = (const bf16_t*)(p.ws + WS_HBUF + HB_Y);
    const int* epos = (const int*)(p.ws + WS_EPOS);
    bf16_t* xb = (bf16_t*)(p.ws + WS_XB);
    int* sbase = (int*)smem; int* stile = sbase + 40;
    moe_prefix(p, layer, sbase, stile);
    const int tid_ = thr(), lane = tid_ & 63, gw = (blockIdx.x * NTHREADS + tid_) >> 6, ngw = (gridDim.x * NTHREADS) >> 6;
    for (int t = gw; t < T; t += ngw) {
        const int ep0 = epos[t * 2], ep1 = epos[t * 2 + 1];
        const size_t s0 = (size_t)(sbase[ep0 >> 16] + (ep0 & 0xffff)), s1 = (size_t)(sbase[ep1 >> 16] + (ep1 & 0xffff));
        float v[2][8]; float s = 0.f;
#pragma unroll
        for (int j = 0; j < 2; ++j) {
            const int k = j * 512 + lane * 8;
            float xa[8], ya[8], yb[8];
            unpack8(*(const u32x4*)(xb + (size_t)t * D_MODEL + k), xa);
            unpack8(*(const u32x4*)(Y + s0 * D_MODEL + k), ya); unpack8(*(const u32x4*)(Y + s1 * D_MODEL + k), yb);
#pragma unroll
            for (int e = 0; e < 8; ++e) { v[j][e] = ALPHA * xa[e] + (ya[e] + yb[e]); s += v[j][e]; }
        }
        const float mu = wave_sum(s) * (1.f / D_MODEL);
        float s2 = 0.f;
#pragma unroll
        for (int j = 0; j < 2; ++j)
#pragma unroll
            for (int e = 0; e < 8; ++e) { v[j][e] -= mu; s2 += v[j][e] * v[j][e]; }
        const float rstd = rsqrtf(wave_sum(s2) * (1.f / D_MODEL) + EPS);
#pragma unroll
        for (int j = 0; j < 2; ++j) {
            const int k = j * 512 + lane * 8;
            const float4 g0 = *(const float4*)(g + k), g1 = *(const float4*)(g + k + 4), b0 = *(const float4*)(bta + k), b1 = *(const float4*)(bta + k + 4);
            const float gg[8] = {g0.x, g0.y, g0.z, g0.w, g1.x, g1.y, g1.z, g1.w}, bb[8] = {b0.x, b0.y, b0.z, b0.w, b1.x, b1.y, b1.z, b1.w};
            float o[8];
#pragma unroll
            for (int e = 0; e < 8; ++e) o[e] = v[j][e] * rstd * gg[e] + bb[e];
            if (final_layer) {
                *(float4*)(p.out + (size_t)t * D_MODEL + k) = make_float4(o[0], o[1], o[2], o[3]);
                *(float4*)(p.out + (size_t)t * D_MODEL + k + 4) = make_float4(o[4], o[5], o[6], o[7]);
            } else {
                u32x4 w; w.x = pk2(o[0], o[1]); w.y = pk2(o[2], o[3]); w.z = pk2(o[4], o[5]); w.w = pk2(o[6], o[7]);
                *(u32x4*)(xb + (size_t)t * D_MODEL + k) = w;
            }
        }
    }
}

__device__ __forceinline__ void ph_prologue(const Params& p, unsigned char* lds) {
    ph_cvt_x(p);
    bf16_t* sT = (bf16_t*)lds;
    unsigned char* ws = p.ws;
    const float* qg = p.in[7]; const float* kvg = p.in[9]; const float* dg = p.in[6];
    constexpr int T0 = 16 * 32, T1 = T0 + 4 * 8, T2 = T1 + 2 * 12, T3 = T2 + 16 * 16, T4 = T3 + 16 * 48, T5 = T4 + 16 * 16;
    auto ident = [](int n) { return n; };
    auto one = [](int) { return 1.f; };
    for (int it = blockIdx.x; it < T5; it += gridDim.x) {
        if (it < T0) cvt_w_tile(p.in[1], 1024, AB_IN, 32, (bf16_t*)(ws + WT_IN_AB), it, ident, one, sT);
        else if (it < T1) cvt_w_tile(p.in[8], 256, 384, 8, (bf16_t*)(ws + WT_UQ), it - T0, ident, [&](int k) { return qg[k]; }, sT);
        else if (it < T2) cvt_w_tile(p.in[10], 128, 768, 12, (bf16_t*)(ws + WT_UKV), it - T1,
                                     [](int n) { const int h = n / 192, i = n % 192; return i < 64 ? h * 64 + i : 256 + h * 128 + (i - 64); }, [&](int k) { return kvg[k]; }, sT);
        else if (it < T3) cvt_w_tile(p.in[11], 1024, 1024, 16, (bf16_t*)(ws + WT_OUT_AB), it - T2, ident, [&](int k) { return k < 512 ? dg[k & 127] * 0.8f : 1.f; }, sT);
        else if (it < T4) cvt_w_tile(p.in[12], 1024, 3072, 48, (bf16_t*)(ws + WT_IN_C), it - T3, ident, one, sT);
        else cvt_w_tile(p.in[13], 1024, 1024, 16, (bf16_t*)(ws + WT_OUT_C), it - T4, ident, one, sT);
    }
}

__device__ __forceinline__ void ph_inproj1_g8(const Params& p, unsigned char* lds) {
    SchedDense S{(const char*)(p.ws + WS_XB), (const char*)(p.ws + WT_IN_C), D_MODEL * 2, D_MODEL * 2, 12, (T / 256) * 12, 0, 0};
    EpiRowBf16 E{(bf16_t*)(p.ws + WS_HBUF), 3072, 3072};
    g8::gemm_phase(( __attribute__((address_space(3))) unsigned char*)lds, D_MODEL, D_MODEL, S, E);
}

__device__ __forceinline__ void ph_outproj1_g8(const Params& p, unsigned char* lds) {
    SchedDense S{(const char*)(p.ws + WS_Q + Q_O1), (const char*)(p.ws + WT_OUT_C), D_MODEL * 2, D_MODEL * 2, 4, (T / 256) * 4, 0, 0};
    EpiResidualBf16<false> E{(const void*)(p.ws + WS_XB), (bf16_t*)(p.ws + WS_HBUF + HB_YB)};
    g8::gemm_phase((__attribute__((address_space(3))) unsigned char*)lds, D_MODEL, D_MODEL, S, E);
}
__device__ __forceinline__ void ph_outproj0_g8(const Params& p, unsigned char* lds) {
    SchedDense S{(const char*)(p.ws + WS_HBUF + HB_AOC), (const char*)(p.ws + WT_OUT_AB), D_MODEL * 2, D_MODEL * 2, 4, (T / 256) * 4, 0, 0};
    EpiResidualBf16<true> E{(const void*)p.in[0], (bf16_t*)(p.ws + WS_HBUF + HB_YB)};
    g8::gemm_phase((__attribute__((address_space(3))) unsigned char*)lds, D_MODEL, D_MODEL, S, E);
}
__device__ __forceinline__ void ph_inproj0_g8(const Params& p, unsigned char* lds) {
    {
        SchedDense S{(const char*)(p.ws + WS_XB), (const char*)(p.ws + WT_IN_AB), D_MODEL * 2, D_MODEL * 2, 8, (T / 256) * 6, 4, 6};
        EpiRowBf16 E{(bf16_t*)(p.ws + WS_HBUF), H0_LD, AB_IN};
        g8::gemm_phase((__attribute__((address_space(3))) unsigned char*)lds, D_MODEL, D_MODEL, S, E);
    }
    {
        SchedDense S{(const char*)(p.ws + WT_IN_AB) + (size_t)1024 * D_MODEL * 2, (const char*)(p.ws + WS_XB), D_MODEL * 2, D_MODEL * 2, T / 256, 2 * (T / 256), 0, 0};
        EpiRowBf16 E{(bf16_t*)(p.ws + WS_Q + Q_VTA), VT_LD, T};
        g8::gemm_phase((__attribute__((address_space(3))) unsigned char*)lds, D_MODEL, D_MODEL, S, E);
    }
}

__device__ __forceinline__ float diff_lambda(const Params& p) {
    float d1 = 0.f, d2 = 0.f;
    for (int i = 0; i < 64; ++i) { d1 += p.in[2][i] * p.in[3][i]; d2 += p.in[4][i] * p.in[5][i]; }
    return expf(d1) - expf(d2) + 0.2f;
}
constexpr int LDS_X = 147456;

struct EpiMlaQ {
    bf16_t* qb; const float* rs;
    __device__ __forceinline__ void operator()(const g8::f32x4 (&acc)[2][2][4][2], const g8::Unit& u, int wr, int wc, int fr, int fq) const {
#pragma unroll
        for (int ai = 0; ai < 2; ++ai)
#pragma unroll
            for (int m = 0; m < 4; ++m) {
                const int tok = u.r0 + 128 * ai + 64 * wr + 16 * m + fr;
                const float r = rs[tok];
#pragma unroll
                for (int bj = 0; bj < 2; ++bj) {
                    const int cb = u.c0 + 128 * bj + 32 * wc;
                    if (cb >= 384) continue;
                    const int g32 = cb >> 5, head = g32 / 3, part = g32 % 3;
                    float v[8];
#pragma unroll
                    for (int e = 0; e < 4; ++e) { v[e] = acc[ai][bj][m][0][e] * r; v[4 + e] = acc[ai][bj][m][1][e] * r; }
                    u32x4 w; w.x = pk2(v[0], v[1]); w.y = pk2(v[2], v[3]); w.z = pk2(v[4], v[5]); w.w = pk2(v[6], v[7]);
                    *(u32x4*)(qb + ((size_t)tok * 4 + head) * 96 + part * 32 + 8 * fq) = w;
                }
            }
    }
};
struct EpiMlaK {
    bf16_t* kb; const float* rs;
    __device__ __forceinline__ void operator()(const g8::f32x4 (&acc)[2][2][4][2], const g8::Unit& u, int wr, int wc, int fr, int fq) const {
#pragma unroll
        for (int ai = 0; ai < 2; ++ai)
#pragma unroll
            for (int m = 0; m < 4; ++m) {
                const int tok = u.r0 + 128 * ai + 64 * wr + 16 * m + fr;
                const float r = rs[tok];
#pragma unroll
                for (int bj = 0; bj < 2; ++bj) {
                    const int c = 128 * bj + 32 * wc + 8 * fq;
                    const g8::f32x4 v0 = acc[ai][bj][m][0], v1 = acc[ai][bj][m][1];
                    u32x4 w; w.x = pk2(v0[0] * r, v0[1] * r); w.y = pk2(v0[2] * r, v0[3] * r); w.z = pk2(v1[0] * r, v1[1] * r); w.w = pk2(v1[2] * r, v1[3] * r);
                    *(u32x4*)(kb + ((size_t)tok * 4 + (c >> 6)) * 96 + (c & 63)) = w;
                }
            }
    }
};
struct EpiMlaVt {
    bf16_t* vt; const float* rs;
    __device__ __forceinline__ void operator()(const g8::f32x4 (&acc)[2][2][4][2], const g8::Unit& u, int wr, int wc, int fr, int fq) const {
#pragma unroll
        for (int bj = 0; bj < 2; ++bj) {
            const int tk = u.c0 + 128 * bj + 32 * wc + 8 * fq;
            const float4 ra = *(const float4*)(rs + tk), rb = *(const float4*)(rs + tk + 4);
#pragma unroll
            for (int ai = 0; ai < 2; ++ai)
#pragma unroll
                for (int m = 0; m < 4; ++m) {
                    const int row = u.r0 + 128 * ai + 64 * wr + 16 * m + fr;
                    const g8::f32x4 v0 = acc[ai][bj][m][0], v1 = acc[ai][bj][m][1];
                    u32x4 w; w.x = pk2(v0[0] * ra.x, v0[1] * ra.y); w.y = pk2(v0[2] * ra.z, v0[3] * ra.w); w.z = pk2(v1[0] * rb.x, v1[1] * rb.y); w.w = pk2(v1[2] * rb.z, v1[3] * rb.w);
                    *(u32x4*)(vt + (size_t)row * VT_LD + tk) = w;
                }
        }
    }
};
__device__ __forceinline__ void ph_mla_pre(const Params& p) {
    const bf16_t* h0 = (const bf16_t*)(p.ws + WS_HBUF);
    bf16_t* kb = (bf16_t*)(p.ws + WS_Q + Q_KB);
    float* rs = (float*)(p.ws + WS_RS);
    const int tid = thr(), lane = tid & 63, gw = (blockIdx.x * NTHREADS + tid) >> 6, ngw = (gridDim.x * NTHREADS) >> 6;
    for (int t = gw; t < T; t += ngw) {
        const bf16_t* row = h0 + (size_t)t * H0_LD + 1536;
        float ss = 0.f;
        if (lane < 48) { float f[8]; unpack8(*(const u32x4*)(row + lane * 8), f);
#pragma unroll
            for (int e = 0; e < 8; ++e) ss += f[e] * f[e]; }
        float sq = lane < 32 ? ss : 0.f, skv = (lane >= 32 && lane < 48) ? ss : 0.f;
        sq = wave_sum(sq); skv = wave_sum(skv);
        if (lane == 0) { rs[t] = rsqrtf(sq * (1.f / 256.f) + EPS); rs[T + t] = rsqrtf(skv * (1.f / 128.f) + EPS); }
    }
    for (int e = blockIdx.x * NTHREADS + tid; e < T * 2; e += gridDim.x * NTHREADS) {
        const int m = e >> 1, hf = e & 1, s = m % SEQ;
        float t1[8], t2[8], o1[8], o2[8];
        unpack8(*(const u32x4*)(h0 + (size_t)m * H0_LD + 1920 + 8 * hf), t1); unpack8(*(const u32x4*)(h0 + (size_t)m * H0_LD + 1936 + 8 * hf), t2);
#pragma unroll
        for (int j = 0; j < 8; ++j) { float c, sn; rope_cs(s, 8 * hf + j, c, sn); o1[j] = t1[j] * c - t2[j] * sn; o2[j] = t1[j] * sn + t2[j] * c; }
        u32x4 a, b;
        a.x = pk2(o1[0], o1[1]); a.y = pk2(o1[2], o1[3]); a.z = pk2(o1[4], o1[5]); a.w = pk2(o1[6], o1[7]);
        b.x = pk2(o2[0], o2[1]); b.y = pk2(o2[2], o2[3]); b.z = pk2(o2[4], o2[5]); b.w = pk2(o2[6], o2[7]);
#pragma unroll
        for (int h = 0; h < 4; ++h) { *(u32x4*)(kb + ((size_t)m * 4 + h) * 96 + 64 + 8 * hf) = a; *(u32x4*)(kb + ((size_t)m * 4 + h) * 96 + 80 + 8 * hf) = b; }
    }
}
__device__ __forceinline__ void ph_mla_up_g8(const Params& p, unsigned char* lds) {
    const char* h0 = (const char*)(p.ws + WS_HBUF);
    const float* rs = (const float*)(p.ws + WS_RS);
    {
        SchedDense S{h0 + 1536 * 2, (const char*)(p.ws + WT_UQ), H0_LD * 2, 256 * 2, 2, (T / 256) * 2, 0, 0};
        EpiMlaQ E{(bf16_t*)(p.ws + WS_Q + Q_QB), rs};
        g8::gemm_phase((__attribute__((address_space(3))) unsigned char*)lds, 256, 256, S, E);
    }
    {
        SchedDense S{h0 + 1792 * 2, (const char*)(p.ws + WT_UKV), H0_LD * 2, 128 * 2, 1, T / 256, 0, 0};
        EpiMlaK E{(bf16_t*)(p.ws + WS_Q + Q_KB), rs + T};
        g8::gemm_phase((__attribute__((address_space(3))) unsigned char*)lds, 128, 128, S, E);
    }
    {
        SchedDense S{(const char*)(p.ws + WT_UKV) + (size_t)256 * 128 * 2, h0 + 1792 * 2, 128 * 2, H0_LD * 2, T / 256, 2 * (T / 256), 0, 0};
        EpiMlaVt E{(bf16_t*)(p.ws + WS_Q + Q_VB), rs + T};
        g8::gemm_phase((__attribute__((address_space(3))) unsigned char*)lds, 128, H0_LD, S, E);
    }
}

constexpr size_t Q_WGU = 0, Q_WD = 64 * MiB;
__device__ __forceinline__ void ph_cvt_moe(const Params& p, int layer, unsigned char* lds) {
    bf16_t* sT = (bf16_t*)lds;
    const float* Wg = p.in[20] + (size_t)layer * MOE_E * D_MODEL * MOE_H; const float* Wu = p.in[21] + (size_t)layer * MOE_E * D_MODEL * MOE_H;
    const float* Wd = p.in[22] + (size_t)layer * MOE_E * MOE_H * D_MODEL;
    bf16_t* wgu = (bf16_t*)(p.ws + WS_Q + Q_WGU); bf16_t* wd = (bf16_t*)(p.ws + WS_Q + Q_WD);
    auto one = [](int) { return 1.f; };
    for (int it = blockIdx.x; it < 3 * 32 * 128; it += gridDim.x) {
        const int which = it / (32 * 128), r = it % (32 * 128), e = r >> 7, tile = r & 127;
        if (which == 0) cvt_w_tile(Wg + (size_t)e * D_MODEL * MOE_H, 1024, 512, 8, wgu + (size_t)e * 1024 * 1024, tile, [](int hd) { return 256 * (hd >> 7) + (hd & 127); }, one, sT);
        else if (which == 1) cvt_w_tile(Wu + (size_t)e * D_MODEL * MOE_H, 1024, 512, 8, wgu + (size_t)e * 1024 * 1024, tile, [](int hd) { return 256 * (hd >> 7) + 128 + (hd & 127); }, one, sT);
        else cvt_w_tile(Wd + (size_t)e * MOE_H * D_MODEL, 512, 1024, 16, wd + (size_t)e * 1024 * 512, tile, [](int n) { return n; }, one, sT);
    }
}

__device__ __forceinline__ void ph_moe_up_g8(const Params& p, int layer, unsigned char* lds) {
    int* sbase = (int*)(lds + LDS_X); int* stile = sbase + 40;
    moe_prefix(p, layer, sbase, stile);
    SchedMoe<true> S{(const char*)(p.ws + WS_XB), (const char*)(p.ws + WS_Q + Q_WGU), D_MODEL * 2, (size_t)1024 * D_MODEL * 2, sbase, stile, (const int*)(p.ws + WS_LTOK)};
    EpiMoeUp E{(bf16_t*)(p.ws + WS_HBUF + HB_H)};
    g8::gemm_phase((__attribute__((address_space(3))) unsigned char*)lds, D_MODEL, D_MODEL, S, E);
}
__device__ __forceinline__ void ph_moe_down_g8(const Params& p, int layer, unsigned char* lds) {
    int* sbase = (int*)(lds + LDS_X); int* stile = sbase + 40;
    moe_prefix(p, layer, sbase, stile);
    SchedMoe<false> S{(const char*)(p.ws + WS_HBUF + HB_H), (const char*)(p.ws + WS_Q + Q_WD), MOE_H * 2, (size_t)1024 * MOE_H * 2, sbase, stile, nullptr};
    EpiMoeDown E{(bf16_t*)(p.ws + WS_HBUF + HB_Y), (const float*)(p.ws + WS_LW)};
    g8::gemm_phase((__attribute__((address_space(3))) unsigned char*)lds, MOE_H, MOE_H, S, E);
}

template <int DQK> __device__ __forceinline__ int kswz(int row, int c) { return DQK == 64 ? row * 128 + ((c ^ ((row >> 1) & 7)) << 4) : row * 192 + ((c ^ ((row >> 2) & 3)) << 4); }
constexpr int ATT_STAGE = 28672, ATT_VOFF = 12288;
constexpr float ATT_THR = 10.0f;

constexpr int ATT_K0 = 0, ATT_K1 = 12288, ATT_V0 = 24576, ATT_V1 = 40960;
template <int DQK, bool BIAS>
__device__ __forceinline__ void attn0_item(const bf16_t* __restrict__ Qp, int ldq, const bf16_t* __restrict__ Kp, const bf16_t* __restrict__ VTp, int ldvt, bf16_t* Op, float scale_l2, float slope_l2, int q0, unsigned char* lds, bool combine, float lam) {
    constexpr int NS = DQK / 16, KCH = DQK / 8, NKL = (64 * KCH + NTHREADS - 1) / NTHREADS;
    const int tid = thr(), lane = tid & 63, wave = tid >> 6, fr = lane & 31, fh = lane >> 5;
    const int pr = (fr & ~12) | ((fr & 4) << 1) | ((fr & 8) >> 1);
    bf16x8 qf[NS];
    {
        const bf16_t* qrow = Qp + (size_t)(q0 + wave * 32 + fr) * ldq + 8 * fh;
#pragma unroll
        for (int s = 0; s < (DQK == 96 ? 4 : NS); ++s) {
            float f[8]; unpack8(*(const u32x4*)(qrow + 16 * s), f);
            u32x4 o; o.x = pk2(f[0] * scale_l2, f[1] * scale_l2); o.y = pk2(f[2] * scale_l2, f[3] * scale_l2); o.z = pk2(f[4] * scale_l2, f[5] * scale_l2); o.w = pk2(f[6] * scale_l2, f[7] * scale_l2);
            qf[s] = __builtin_bit_cast(bf16x8, o);
        }
        if (DQK == 96) {
            float f1[8], f2[8], o1[8], o2[8];
            unpack8(*(const u32x4*)(qrow + 64), f1); unpack8(*(const u32x4*)(qrow + 80), f2);
            const int spos = q0 + wave * 32 + fr;
#pragma unroll
            for (int j = 0; j < 8; ++j) {
                float c, sn; rope_cs(spos, 8 * fh + j, c, sn);
                o1[j] = (f1[j] * c - f2[j] * sn) * scale_l2; o2[j] = (f1[j] * sn + f2[j] * c) * scale_l2;
            }
            u32x4 a, b;
            a.x = pk2(o1[0], o1[1]); a.y = pk2(o1[2], o1[3]); a.z = pk2(o1[4], o1[5]); a.w = pk2(o1[6], o1[7]);
            b.x = pk2(o2[0], o2[1]); b.y = pk2(o2[2], o2[3]); b.z = pk2(o2[4], o2[5]); b.w = pk2(o2[6], o2[7]);
            qf[NS - 2] = __builtin_bit_cast(bf16x8, a); qf[NS - 1] = __builtin_bit_cast(bf16x8, b);
        }
    }
    f32x16 O[4];
#pragma unroll
    for (int d = 0; d < 4; ++d)
#pragma unroll
        for (int r = 0; r < 16; ++r) O[d][r] = 0.f;
    float m = -1e30f, l = 0.f;
    const float qposf = (float)(q0 + wave * 32 + fr);
    u32x4 kr[NKL], vr[2];
    auto gloadK = [&](int k0) {
#pragma unroll
        for (int i = 0; i < NKL; ++i) { const int idx = tid + NTHREADS * i, row = idx / KCH, c = idx % KCH; if (idx < 64 * KCH) kr[i] = *(const u32x4*)(Kp + (size_t)(k0 + row) * ldq + c * 8); }
    };
    auto gloadV = [&](int k0) {
#pragma unroll
        for (int i = 0; i < 2; ++i) { const int row = (tid >> 3) + 64 * i, c = tid & 7; vr[i] = *(const u32x4*)(VTp + (size_t)row * ldvt + k0 + c * 8); }
    };
    auto lstoreK = [&](unsigned char* st) {
#pragma unroll
        for (int i = 0; i < NKL; ++i) { const int idx = tid + NTHREADS * i, row = idx / KCH, c = idx % KCH; if (idx < 64 * KCH) *(u32x4*)(st + kswz<DQK>(row, c)) = kr[i]; }
    };
    auto lstoreV = [&](unsigned char* st) {
#pragma unroll
        for (int i = 0; i < 2; ++i) { const int row = (tid >> 3) + 64 * i, c = tid & 7; *(u32x4*)(st + swz128(row, c)) = vr[i]; }
    };
    auto qk = [&](const unsigned char* kt, f32x16& S0, f32x16& S1) {
#pragma unroll
        for (int r = 0; r < 16; ++r) { S0[r] = 0.f; S1[r] = 0.f; }
#pragma unroll
        for (int s = 0; s < NS; ++s) {
            const bf16x8 k0f = *(const bf16x8*)(kt + kswz<DQK>(pr, 2 * s + fh));
            const bf16x8 k1f = *(const bf16x8*)(kt + kswz<DQK>(32 + pr, 2 * s + fh));
            S0 = MFMA32(k0f, qf[s], S0);
            S1 = MFMA32(k1f, qf[s], S1);
        }
    };
    constexpr int NT = SEQ / 64;
    gloadK(0); gloadV(0);
    __syncthreads();
    lstoreK(lds + ATT_K0); lstoreV(lds + ATT_V0);
    gloadK(64);
    lstoreK(lds + ATT_K1);
    __syncthreads();
    f32x16 SA0, SA1, SB0, SB1;
    qk(lds + ATT_K0, SA0, SA1);
    const bool late = __builtin_amdgcn_readfirstlane(wave) >= 4;
    if (late) __builtin_amdgcn_s_setprio(1);
    auto tile = [&](int t, f32x16& Sc0, f32x16& Sc1, f32x16& Sn0, f32x16& Sn1) {
        const bool more1 = t + 1 < NT, more2 = t + 2 < NT;
        if (more2) gloadK((t + 2) * 64);
        if (more1) gloadV((t + 1) * 64);
        if (more1 && !late) qk(lds + (((t + 1) & 1) ? ATT_K1 : ATT_K0), Sn0, Sn1);
        float mx = -1e30f;
        if (BIAS) {
            const float dq = (float)(t * 64 + 8 * fh) - qposf;
#pragma unroll
            for (int r = 0; r < 16; ++r) {
                const float c0 = (float)(16 * (r >> 3) + (r & 7));
                Sc0[r] = fmaf(fabsf(dq + c0), -slope_l2, Sc0[r]);
                Sc1[r] = fmaf(fabsf(dq + c0 + 32.f), -slope_l2, Sc1[r]);
                mx = fmaxf(mx, fmaxf(Sc0[r], Sc1[r]));
            }
        } else {
#pragma unroll
            for (int r = 0; r < 16; ++r) mx = fmaxf(mx, fmaxf(Sc0[r], Sc1[r]));
        }
        mx = fmaxf(mx, __shfl_xor(mx, 32));
        if (__any(mx > m + ATT_THR)) {
            const float mn = fmaxf(m, mx), alpha = __builtin_amdgcn_exp2f(m - mn);
            m = mn; l *= alpha;
#pragma unroll
            for (int d = 0; d < 4; ++d)
#pragma unroll
                for (int r = 0; r < 16; ++r) O[d][r] *= alpha;
        }
        float ls = 0.f;
#pragma unroll
        for (int r = 0; r < 16; ++r) { Sc0[r] = __builtin_amdgcn_exp2f(Sc0[r] - m); Sc1[r] = __builtin_amdgcn_exp2f(Sc1[r] - m); ls += Sc0[r] + Sc1[r]; }
        l += ls;
        bf16x8 pf[2][2];
#pragma unroll
        for (int s2 = 0; s2 < 2; ++s2) {
            u32x4 a, b;
            a.x = pk2(Sc0[8 * s2 + 0], Sc0[8 * s2 + 1]); a.y = pk2(Sc0[8 * s2 + 2], Sc0[8 * s2 + 3]); a.z = pk2(Sc0[8 * s2 + 4], Sc0[8 * s2 + 5]); a.w = pk2(Sc0[8 * s2 + 6], Sc0[8 * s2 + 7]);
            b.x = pk2(Sc1[8 * s2 + 0], Sc1[8 * s2 + 1]); b.y = pk2(Sc1[8 * s2 + 2], Sc1[8 * s2 + 3]); b.z = pk2(Sc1[8 * s2 + 4], Sc1[8 * s2 + 5]); b.w = pk2(Sc1[8 * s2 + 6], Sc1[8 * s2 + 7]);
            pf[0][s2] = __builtin_bit_cast(bf16x8, a); pf[1][s2] = __builtin_bit_cast(bf16x8, b);
        }
        const unsigned char* vt = lds + ((t & 1) ? ATT_V1 : ATT_V0);
#pragma unroll
        for (int kb = 0; kb < 2; ++kb)
#pragma unroll
            for (int s2 = 0; s2 < 2; ++s2)
#pragma unroll
                for (int d = 0; d < 4; ++d) {
                    const bf16x8 vf = *(const bf16x8*)(vt + swz128(32 * d + fr, 4 * kb + 2 * s2 + fh));
                    O[d] = MFMA32(vf, pf[kb][s2], O[d]);
                }
        if (more1 && late) qk(lds + (((t + 1) & 1) ? ATT_K1 : ATT_K0), Sn0, Sn1);
        if (more2) lstoreK(lds + ((t & 1) ? ATT_K1 : ATT_K0));
        if (more1) lstoreV(lds + ((t & 1) ? ATT_V0 : ATT_V1));
        __syncthreads();
    };
#pragma unroll 1
    for (int t = 0; t < NT; t += 2) {
        tile(t, SA0, SA1, SB0, SB1);
        tile(t + 1, SB0, SB1, SA0, SA1);
    }
    __builtin_amdgcn_s_setprio(0);
    l += __shfl_xor(l, 32);
    const float inv = 1.f / l;
    bf16_t* orow = Op + (size_t)(q0 + wave * 32 + fr) * D_MODEL + 4 * fh;
    if (combine) {
        float ss = 0.f;
#pragma unroll
        for (int d = 0; d < 4; ++d)
#pragma unroll
            for (int q = 0; q < 4; ++q) {
                const uint2 o1 = *(const uint2*)(orow + 32 * d + 8 * q);
                const float d0 = __uint_as_float(o1.x << 16) - lam * (O[d][4 * q] * inv), d1 = __uint_as_float(o1.x & 0xffff0000u) - lam * (O[d][4 * q + 1] * inv);
                const float d2 = __uint_as_float(o1.y << 16) - lam * (O[d][4 * q + 2] * inv), d3 = __uint_as_float(o1.y & 0xffff0000u) - lam * (O[d][4 * q + 3] * inv);
                O[d][4 * q] = d0; O[d][4 * q + 1] = d1; O[d][4 * q + 2] = d2; O[d][4 * q + 3] = d3;
                ss += (d0 * d0 + d1 * d1) + (d2 * d2 + d3 * d3);
            }
        ss += __shfl_xor(ss, 32);
        const float r = rsqrtf(ss * (1.f / 128.f) + EPS);
#pragma unroll
        for (int d = 0; d < 4; ++d)
#pragma unroll
            for (int q = 0; q < 4; ++q) { uint2 o; o.x = pk2(O[d][4 * q] * r, O[d][4 * q + 1] * r); o.y = pk2(O[d][4 * q + 2] * r, O[d][4 * q + 3] * r); *(uint2*)(orow + 32 * d + 8 * q) = o; }
    } else {
#pragma unroll
        for (int d = 0; d < 4; ++d)
#pragma unroll
            for (int q = 0; q < 4; ++q) { uint2 o; o.x = pk2(O[d][4 * q] * inv, O[d][4 * q + 1] * inv); o.y = pk2(O[d][4 * q + 2] * inv, O[d][4 * q + 3] * inv); *(uint2*)(orow + 32 * d + 8 * q) = o; }
    }
}

__device__ __forceinline__ void ph_attn0_f(const Params& p, unsigned char* lds) {
    const bf16_t* h0 = (const bf16_t*)(p.ws + WS_HBUF);
    const bf16_t* qb = (const bf16_t*)(p.ws + WS_Q + Q_QB);
    const bf16_t* kb = (const bf16_t*)(p.ws + WS_Q + Q_KB);
    const bf16_t* vtB = (const bf16_t*)(p.ws + WS_Q + Q_VB);
    const bf16_t* vtA = (const bf16_t*)(p.ws + WS_Q + Q_VTA);
    bf16_t* aoc = (bf16_t*)(p.ws + WS_HBUF + HB_AOC);
    const float lam = diff_lambda(p);
    const int G = gridDim.x, bid = blockIdx.x;
    const bool xmap = (G % 128) == 0;
    const int cpr = xmap ? (G / 8) / 16 : 0;
    for (int k = 0;; ++k) {
        int pairidx, qblk;
        if (xmap) { const int xcd = bid & 7, j = bid >> 3; pairidx = (k * 8 + xcd) * cpr + (j >> 4); qblk = j & 15; }
        else { const int it = bid + k * G; pairidx = it >> 4; qblk = it & 15; }
        if (pairidx >= 48) break;
        const int b = pairidx / 6, pp = pairidx % 6;
#pragma unroll 1
        for (int half = 0; half < 2; ++half) {
            if (pp < 4) {
                const int h = pp, map = half;
                const bf16_t* Qp = h0 + (size_t)b * SEQ * H0_LD + h * 128 + map * 64;
                attn0_item<64, true>(Qp, H0_LD, Qp + 512, vtA + (size_t)(h * 128) * VT_LD + (size_t)b * SEQ, VT_LD, aoc + (size_t)b * SEQ * D_MODEL + h * 128,
                                     0.125f * 1.4426950408889634f, exp2f(-2.0f * (float)(h + 1)) * 1.4426950408889634f, qblk * 256, lds, map == 1, lam);
            } else {
                const int h = 2 * (pp - 4) + half;
                attn0_item<96, false>(qb + ((size_t)b * SEQ * 4 + h) * 96, 384, kb + ((size_t)b * SEQ * 4 + h) * 96, vtB + (size_t)(h * 128) * VT_LD + (size_t)b * SEQ, VT_LD,
                                      aoc + (size_t)b * SEQ * D_MODEL + 512 + h * 128, 0.10206207261596575f * 1.4426950408889634f, 0.f, qblk * 256, lds, false, 0.f);
            }
        }
    }
}

constexpr int DIL_VOFF = 49152, DIL_SCR = 98304;
__device__ __forceinline__ int vswz(int row, int c) { return row * 128 + ((c ^ (((row >> 1) & 1) << 2)) << 4); }

struct DilRegs { u32x4 kr[6], vr[6]; bf16x8 qf[4]; };
__device__ __forceinline__ void dil_load(const Params& p, int pat, int b, int h, int j, DilRegs& R) {
    const bf16_t* h1 = (const bf16_t*)(p.ws + WS_HBUF);
    const int l2d = 2 * pat, SD = SEQ >> l2d, nqb = SD >> 8, res = j / nqb, qblk = j % nqb, m0 = qblk * 256;
    const int tid = thr(), lane = tid & 63, wave = tid >> 6, fr = lane & 31, fh = lane >> 5, c = tid & 7;
    const size_t tokbase = (size_t)b * SEQ + res;
#pragma unroll
    for (int i = 0; i < 6; ++i) {
        const int rowl = (tid >> 3) + 64 * i;
        int m = m0 - 64 + rowl; m = m < 0 ? 0 : (m >= SD ? SD - 1 : m);
        const bf16_t* src = h1 + (tokbase + ((size_t)m << l2d)) * 3072 + 1024 + h * 64 + c * 8;
        R.kr[i] = *(const u32x4*)src; R.vr[i] = *(const u32x4*)(src + 1024);
    }
    const bf16_t* qrow = h1 + (tokbase + ((size_t)(m0 + wave * 32 + fr) << l2d)) * 3072 + h * 64 + 8 * fh;
#pragma unroll
    for (int s = 0; s < 4; ++s) R.qf[s] = *(const bf16x8*)(qrow + 16 * s);
}

template <bool FINAL>
__device__ __forceinline__ void dil_item(const Params& p, int pat, int b, int h, int j, DilRegs& R, bool has_next, int npat, int nb, int nh, int nj, unsigned char* lds) {
    const int l2d = 2 * pat, d = 1 << l2d, SD = SEQ >> l2d;
    const int nqb = SD >> 8, res = j / nqb, qblk = j % nqb, m0 = qblk * 256;
    const int tid = thr(), lane = tid & 63, wave = tid >> 6, fr = lane & 31, fh = lane >> 5;
    const int pr = (fr & ~12) | ((fr & 4) << 1) | ((fr & 8) >> 1);
    const size_t tokbase = (size_t)b * SEQ + res;
    __syncthreads();
    {
        const int c = tid & 7;
#pragma unroll
        for (int i = 0; i < 6; ++i) {
            const int rowl = (tid >> 3) + 64 * i;
            *(u32x4*)(lds + swz128(rowl, c)) = R.kr[i]; *(u32x4*)(lds + DIL_VOFF + vswz(rowl, c)) = R.vr[i];
        }
    }
    bf16x8 qf[4];
#pragma unroll
    for (int s = 0; s < 4; ++s) qf[s] = R.qf[s];
    const int mq = m0 + wave * 32 + fr;
    const size_t qtok = tokbase + ((size_t)mq << l2d);
    __syncthreads();
    if (has_next) dil_load(p, npat, nb, nh, nj, R);
    const float scale_l2 = 0.125f * 1.4426950408889634f;
    const float sl = exp2f(-0.5f * (float)(h + 1)) * 1.4426950408889634f * (float)d;
    const float dmb = (float)(8 * fh - 64 - fr);
    const int mkb = m0 + wave * 32 - 64 + 8 * fh;
    float mx = -1e30f, l = 0.f;
    f32x16 O[2];
#pragma unroll
    for (int dv = 0; dv < 2; ++dv)
#pragma unroll
        for (int r = 0; r < 16; ++r) O[dv][r] = 0.f;
    const int tq = (lane & 15) >> 2, pp = lane & 3, blk = (lane >> 4) & 1, qq = (tq >> 1) & 1;
    const unsigned vb0 = (unsigned)(size_t)(lds + DIL_VOFF) + (unsigned)((32 * wave + 8 * fh + tq) * 128 + ((4 * (0 ^ qq) + 2 * blk + (pp >> 1)) << 4) + 8 * (pp & 1));
    const unsigned vb1 = (unsigned)(size_t)(lds + DIL_VOFF) + (unsigned)((32 * wave + 8 * fh + tq) * 128 + ((4 * (1 ^ qq) + 2 * blk + (pp >> 1)) << 4) + 8 * (pp & 1));
#ifndef DPROBE
#define DPROBE 0
#endif
#pragma unroll
    for (int u = 0; u < ((DPROBE & 1) ? 0 : 5); ++u) {
        f32x16 S;
#pragma unroll
        for (int r = 0; r < 16; ++r) S[r] = 0.f;
#pragma unroll
        for (int s = 0; s < 4; ++s) {
            const bf16x8 kf = *(const bf16x8*)(lds + swz128(32 * (wave + u) + pr, 2 * s + fh));
            S = MFMA32(kf, qf[s], S);
        }
        float tm = -1e30f;
        float dmu = dmb + (float)(32 * u); int mku = mkb + 32 * u;
        asm volatile("" : "+v"(dmu), "+v"(mku));
#pragma unroll
        for (int r = 0; r < 16; ++r) {
            const int cst = 16 * (r >> 3) + (r & 7);
            const float ad = fabsf(dmu + (float)cst);
            const bool ok = (ad <= 64.f) && ((unsigned)(mku + cst) < (unsigned)SD);
            const float t = ok ? fmaf(ad, -sl, S[r] * scale_l2) : -1e30f;
            S[r] = t; tm = fmaxf(tm, t);
        }
        tm = fmaxf(tm, __shfl_xor(tm, 32));
        const float mn = fmaxf(mx, tm), alpha = __builtin_amdgcn_exp2f(mx - mn);
        mx = mn;
        float ls = 0.f;
#pragma unroll
        for (int r = 0; r < 16; ++r) { const float pv = __builtin_amdgcn_exp2f(S[r] - mn); S[r] = pv; ls += pv; }
        l = l * alpha + ls;
#pragma unroll
        for (int dv = 0; dv < 2; ++dv)
#pragma unroll
            for (int r = 0; r < 16; ++r) O[dv][r] *= alpha;
        typedef short s16x4 __attribute__((ext_vector_type(4)));
        s16x4 a0, a1, a2, a3, b0, b1, b2, b3;
        asm volatile(
            "ds_read_b64_tr_b16 %0, %8 offset:%10\n\t"
            "ds_read_b64_tr_b16 %1, %8 offset:%11\n\t"
            "ds_read_b64_tr_b16 %2, %8 offset:%12\n\t"
            "ds_read_b64_tr_b16 %3, %8 offset:%13\n\t"
            "ds_read_b64_tr_b16 %4, %9 offset:%10\n\t"
            "ds_read_b64_tr_b16 %5, %9 offset:%11\n\t"
            "ds_read_b64_tr_b16 %6, %9 offset:%12\n\t"
            "ds_read_b64_tr_b16 %7, %9 offset:%13\n\t"
            "s_waitcnt lgkmcnt(0)"
            : "=&v"(a0), "=&v"(a1), "=&v"(a2), "=&v"(a3), "=&v"(b0), "=&v"(b1), "=&v"(b2), "=&v"(b3)
            : "v"(vb0), "v"(vb1), "i"((32 * u + 0) * 128), "i"((32 * u + 4) * 128), "i"((32 * u + 16) * 128), "i"((32 * u + 20) * 128)
            : "memory");
        bf16x8 pf0, pf1;
        {
            u32x4 a, c2;
            a.x = pk2(S[0], S[1]); a.y = pk2(S[2], S[3]); a.z = pk2(S[4], S[5]); a.w = pk2(S[6], S[7]);
            c2.x = pk2(S[8], S[9]); c2.y = pk2(S[10], S[11]); c2.z = pk2(S[12], S[13]); c2.w = pk2(S[14], S[15]);
            pf0 = __builtin_bit_cast(bf16x8, a); pf1 = __builtin_bit_cast(bf16x8, c2);
        }
        const bf16x8 v00 = __builtin_shufflevector(a0, a1, 0, 1, 2, 3, 4, 5, 6, 7), v01 = __builtin_shufflevector(a2, a3, 0, 1, 2, 3, 4, 5, 6, 7);
        const bf16x8 v10 = __builtin_shufflevector(b0, b1, 0, 1, 2, 3, 4, 5, 6, 7), v11 = __builtin_shufflevector(b2, b3, 0, 1, 2, 3, 4, 5, 6, 7);
        O[0] = MFMA32(v00, pf0, O[0]); O[0] = MFMA32(v01, pf1, O[0]);
        O[1] = MFMA32(v10, pf0, O[1]); O[1] = MFMA32(v11, pf1, O[1]);
    }
    l += __shfl_xor(l, 32);
    const float inv = 1.f / l;
    const float lse = mx + __builtin_amdgcn_logf(l);
    bf16_t* opart = (bf16_t*)(p.ws + WS_Q + Q_OPART);
    float* lsb = (float*)(p.ws + WS_Q + Q_LSE);
    unsigned char* wscr = lds + DIL_SCR + wave * 4864;
    float* wgt = (float*)(wscr + 4608);
    float c0 = inv;
    if (FINAL) {
        const float l1 = lsb[qtok * 16 + h], l2 = lsb[((size_t)T + qtok) * 16 + h];
        const float M = fmaxf(lse, fmaxf(l1, l2));
        const float w0 = __builtin_amdgcn_exp2f(lse - M), w1 = __builtin_amdgcn_exp2f(l1 - M), w2 = __builtin_amdgcn_exp2f(l2 - M);
        const float wi = 1.f / (w0 + w1 + w2);
        c0 = w0 * wi * inv;
        if (fh == 0) { wgt[2 * fr] = w1 * wi; wgt[2 * fr + 1] = w2 * wi; }
    } else {
        if (fh == 0) lsb[((size_t)(pat - 1) * T + qtok) * 16 + h] = lse;
    }
#pragma unroll
    for (int dv = 0; dv < 2; ++dv)
#pragma unroll
        for (int q4 = 0; q4 < 4; ++q4) {
            uint2 o; o.x = pk2(O[dv][4 * q4] * c0, O[dv][4 * q4 + 1] * c0); o.y = pk2(O[dv][4 * q4 + 2] * c0, O[dv][4 * q4 + 3] * c0);
            *(uint2*)(wscr + fr * 144 + (32 * dv + 8 * q4 + 4 * fh) * 2) = o;
        }
    asm volatile("s_waitcnt lgkmcnt(0)" ::: "memory");
#pragma unroll
    for (int it = 0; it < 4; ++it) {
        const int r = it * 8 + (lane >> 3), ch = lane & 7;
        const size_t rtok = tokbase + ((size_t)(m0 + wave * 32 + r) << l2d);
        const u32x4 v = *(const u32x4*)(wscr + r * 144 + ch * 16);
        if (!FINAL) {
            *(u32x4*)(opart + ((size_t)(pat - 1) * T + rtok) * D_MODEL + h * 64 + ch * 8) = v;
        } else {
            const float c1 = wgt[2 * r], c2 = wgt[2 * r + 1];
            float f0[8], f1[8], f2[8];
            unpack8(v, f0);
            unpack8(*(const u32x4*)(opart + rtok * D_MODEL + h * 64 + ch * 8), f1);
            unpack8(*(const u32x4*)(opart + ((size_t)T + rtok) * D_MODEL + h * 64 + ch * 8), f2);
            u32x4 o;
            o.x = pk2(f0[0] + c1 * f1[0] + c2 * f2[0], f0[1] + c1 * f1[1] + c2 * f2[1]); o.y = pk2(f0[2] + c1 * f1[2] + c2 * f2[2], f0[3] + c1 * f1[3] + c2 * f2[3]);
            o.z = pk2(f0[4] + c1 * f1[4] + c2 * f2[4], f0[5] + c1 * f1[5] + c2 * f2[5]); o.w = pk2(f0[6] + c1 * f1[6] + c2 * f2[6], f0[7] + c1 * f1[7] + c2 * f2[7]);
            *(u32x4*)((bf16_t*)(p.ws + WS_Q + Q_O1) + rtok * D_MODEL + h * 64 + ch * 8) = o;
        }
    }
}

template <bool FINAL>
__device__ __forceinline__ void ph_dil_f(const Params& p, unsigned char* lds) {
    const int G = gridDim.x, bid = blockIdx.x;
    const int ngroups = FINAL ? 128 : 256;
    const bool xmap = (G % 128) == 0;
    const int cpr = xmap ? (G / 8) / 16 : 0;
    auto decode = [&](int k, int& pat, int& bb, int& hh, int& j) -> bool {
        int grp;
        if (xmap) { const int xcd = bid & 7, jj = bid >> 3; grp = (k * 8 + xcd) * cpr + (jj >> 4); j = jj & 15; }
        else { const int it = bid + k * G; grp = it >> 4; j = it & 15; }
        if (grp >= ngroups) return false;
        const int bh = grp & 127; pat = FINAL ? 0 : 1 + (grp >> 7); bb = bh >> 4; hh = bh & 15;
        return true;
    };
    DilRegs R;
    int pat, bb, hh, j;
    if (!decode(0, pat, bb, hh, j)) return;
    dil_load(p, pat, bb, hh, j, R);
    for (int k = 0;; ++k) {
        int np = 0, nb = 0, nh = 0, nj = 0;
        const bool has_next = decode(k + 1, np, nb, nh, nj);
        dil_item<FINAL>(p, pat, bb, hh, j, R, has_next, np, nb, nh, nj, lds);
        if (!has_next) break;
        pat = np; bb = nb; hh = nh; j = nj;
    }
}

#define LAS __attribute__((address_space(3)))
#define XB_TMO      128
#define XB_XCNT(j)  (256  + 64 * (j))
#define XB_XSUB(j)  (1280 + 64 * (j))
#define XB_XGEN(j)  (2304 + 64 * (j))
#define XB_TOP      3328
#define XB_TOPGEN   3392
#define XB_SPIN_CAP (1u << 22)
constexpr int CW_BAR = 4096;
__device__ __forceinline__ unsigned xb_ld(unsigned* p)              { return __hip_atomic_load(p, __ATOMIC_RELAXED, __HIP_MEMORY_SCOPE_AGENT); }
__device__ __forceinline__ unsigned xb_add(unsigned* p, unsigned v) { return __hip_atomic_fetch_add(p, v, __ATOMIC_RELAXED, __HIP_MEMORY_SCOPE_AGENT); }
__device__ __forceinline__ unsigned xb_xcc_id() { return (unsigned)__builtin_amdgcn_s_getreg((3 << 11) | 20) & 0xFu; }
#define XB_SPIN(cond, bar) do { unsigned _sp = 0; while (cond) { __builtin_amdgcn_s_sleep(1); \
    if ((++_sp & 255u) == 0u) { if (xb_ld(&(bar)[XB_TMO])) break; if (_sp > XB_SPIN_CAP) { atomicAdd(&(bar)[XB_TMO], 1u); break; } } } } while (0)
struct XcdBarrier { unsigned* bar; unsigned x; volatile LAS unsigned* st; };
__device__ __forceinline__ XcdBarrier xcd_barrier_post(unsigned* bar, volatile LAS unsigned* st) {
    XcdBarrier b; b.bar = bar; b.x = xb_xcc_id(); b.st = st;
    if (threadIdx.x == 0) (void)xb_add(&bar[XB_XCNT(b.x)], 1u);
    return b;
}
__device__ __forceinline__ void xcd_barrier_complete(unsigned* bar, unsigned x, unsigned& nloc, unsigned& nx) {
    const unsigned G = gridDim.x * gridDim.y * gridDim.z;
    unsigned sum, cnt, mine, sp = 0u;
    for (;;) {
        sum = 0u; cnt = 0u; mine = 0u;
#pragma unroll
        for (unsigned j = 0; j < 16; ++j) { const unsigned c = xb_ld(&bar[XB_XCNT(j)]); sum += c; cnt += (c > 0u) ? 1u : 0u; mine = (j == x) ? c : mine; }
        if (sum == G) break;
        __builtin_amdgcn_s_sleep(1);
        if ((++sp & 255u) == 0u) { if (xb_ld(&bar[XB_TMO])) break; if (sp > XB_SPIN_CAP) { atomicAdd(&bar[XB_TMO], 1u); break; } }
    }
    nloc = mine > 0u ? mine : 1u; nx = cnt > 0u ? cnt : 1u;
}
__device__ __forceinline__ void xcd_barrier(const XcdBarrier& b) {
    asm volatile("s_waitcnt vmcnt(0)" ::: "memory");
    __syncthreads();
    if (threadIdx.x == 0) {
        unsigned* bar = b.bar;
        __builtin_amdgcn_s_waitcnt(0);
        unsigned nloc = b.st[0], nx = b.st[1];
        if (nloc == 0u) { xcd_barrier_complete(bar, b.x, nloc, nx); b.st[0] = nloc; b.st[1] = nx; }
        const unsigned old = xb_add(&bar[XB_XSUB(b.x)], 1u);
        const unsigned gen = old / nloc;
        if (old + 1u == (gen + 1u) * nloc) {
            __builtin_amdgcn_fence(__ATOMIC_RELEASE, "agent");
            asm volatile("s_waitcnt vmcnt(0)" ::: "memory");
            const unsigned og = xb_add(&bar[XB_TOP], 1u);
            const unsigned tg = og / nx;
            if (og + 1u == (tg + 1u) * nx) xb_add(&bar[XB_TOPGEN], 1u);
            else XB_SPIN(xb_ld(&bar[XB_TOPGEN]) == tg, bar);
            __builtin_amdgcn_fence(__ATOMIC_ACQUIRE, "agent");
            xb_add(&bar[XB_XGEN(b.x)], 1u);
            asm volatile("s_waitcnt vmcnt(0)" ::: "memory");
        } else {
            XB_SPIN(xb_ld(&bar[XB_XGEN(b.x)]) == gen, bar);
            __builtin_amdgcn_fence(__ATOMIC_ACQUIRE, "agent");
            asm volatile("s_waitcnt vmcnt(0)" ::: "memory");
        }
    }
    __syncthreads();
}

__device__ __forceinline__ void ph_router_tables(const Params& p) {
    const int tid = thr();
    for (int layer = 0; layer < 2; ++layer) {
        const float* g = p.in[14] + layer * D_MODEL; const float* bta = p.in[15] + layer * D_MODEL;
        const float* wg = p.in[16] + (size_t)layer * D_MODEL * 4; const float* bg = p.in[17] + layer * 4;
        const float* wr = p.in[18] + (size_t)layer * D_MODEL * 32; const float* br = p.in[19] + layer * 32;
        float* tab = (float*)(p.ws + WS_RTAB) + (size_t)layer * D_MODEL * 36;
        float* cst = (float*)(p.ws + WS_RCONST) + layer * 72;
        for (int e = blockIdx.x * NTHREADS + tid; e < D_MODEL * 36; e += gridDim.x * NTHREADS) {
            const int k = e / 36, c = e % 36;
            tab[e] = g[k] * (c < 4 ? wg[k * 4 + c] : wr[k * 32 + (c - 4)]);
        }
        const int gw = (blockIdx.x * NTHREADS + tid) >> 6, lane = tid & 63;
        if (gw >= layer * 36 && gw < layer * 36 + 36) {
            const int c = gw - layer * 36; float s1 = 0.f, s0 = 0.f;
            for (int k = lane; k < D_MODEL; k += 64) { const float w = c < 4 ? wg[k * 4 + c] : wr[k * 32 + (c - 4)]; s1 += g[k] * w; s0 += bta[k] * w; }
            s1 = wave_sum(s1); s0 = wave_sum(s0);
            if (lane == 0) { cst[c] = s1; cst[36 + c] = s0 + (c < 4 ? bg[c] : br[c - 4]); }
        }
    }
}

__device__ __forceinline__ void ph_ln_router_f(const Params& p, int layer, unsigned char* lds, bool dry = false) {
    const float* g = p.in[14] + layer * D_MODEL; const float* bta = p.in[15] + layer * D_MODEL;
    const float* tab = (const float*)(p.ws + WS_RTAB) + (size_t)layer * D_MODEL * 36;
    const float* cst = (const float*)(p.ws + WS_RCONST) + layer * 72;
    unsigned* cnt = (unsigned*)(p.ws + WS_CTL) + CW_CNT + layer * 32;
    int* ltok = (int*)(p.ws + WS_LTOK); float* lw = (float*)(p.ws + WS_LW); int* epos = (int*)(p.ws + WS_EPOS);
    bf16_t* xb = (bf16_t*)(p.ws + WS_XB);
    const bf16_t* yb = (const bf16_t*)(p.ws + WS_HBUF + HB_YB);
    float* ltab = (float*)lds;
    int* part = (int*)(lds + 147456);
    float* stats = (float*)(lds + 147456 + 9728);
    const int tid = thr(), lane = tid & 63, wave = __builtin_amdgcn_readfirstlane(tid >> 6);
    __syncthreads();
    for (int i = tid; i < D_MODEL * 36 / 4; i += NTHREADS) ((float4*)ltab)[i] = ((const float4*)tab)[i];
    for (int it = blockIdx.x; it < T / 64; it += gridDim.x) {
        const int t0 = it * 64;
        __syncthreads();
        for (int i = tid; i < 38 * 64; i += NTHREADS) part[i] = 0;
        __syncthreads();
        {
            const bf16_t* yrow = yb + (size_t)(t0 + lane) * D_MODEL + wave * 128;
            const float* wt = ltab + wave * 128 * 36;
            float acc[36], s = 0.f, ss = 0.f;
#pragma unroll
            for (int c = 0; c < 36; ++c) acc[c] = 0.f;
#pragma unroll 1
            for (int k4 = 0; k4 < 128; k4 += 8) {
                float yv[8]; unpack8(*(const u32x4*)(yrow + k4), yv);
#pragma unroll
                for (int i = 0; i < 8; ++i) {
                    s += yv[i]; ss = fmaf(yv[i], yv[i], ss);
#pragma unroll
                    for (int c = 0; c < 36; ++c) acc[c] = fmaf(yv[i], wt[(k4 + i) * 36 + c], acc[c]);
                }
            }
            int* pw = part + lane;
#pragma unroll
            for (int c = 0; c < 36; ++c) atomicAdd(pw + c * 64, __float2int_rn(acc[c] * 4194304.f));
            atomicAdd(pw + 36 * 64, __float2int_rn(s * 4194304.f)); atomicAdd(pw + 37 * 64, __float2int_rn(ss * 65536.f));
        }
        __syncthreads();
        if (dry) continue;
        if (wave == 0) {
            float v[38];
#pragma unroll
            for (int c = 0; c < 38; ++c) v[c] = (float)part[c * 64 + lane] * (c == 37 ? (1.f / 65536.f) : (1.f / 4194304.f));
            const float mu = v[36] * (1.f / D_MODEL), var = fmaxf(v[37] * (1.f / D_MODEL) - mu * mu, 0.f), rstd = rsqrtf(var + EPS);
            stats[lane * 2] = mu; stats[lane * 2 + 1] = rstd;
            float lg[36];
#pragma unroll
            for (int c = 0; c < 36; ++c) lg[c] = rstd * (v[c] - mu * cst[c]) + cst[36 + c];
            int gs = 0; float cm = lg[0];
            if (lg[1] > cm) { cm = lg[1]; gs = 1; }
            if (lg[2] > cm) { cm = lg[2]; gs = 2; }
            if (lg[3] > cm) { cm = lg[3]; gs = 3; }
            const float pg = 1.f / (expf(lg[0] - cm) + expf(lg[1] - cm) + expf(lg[2] - cm) + expf(lg[3] - cm));
            float f[8];
#pragma unroll
            for (int i = 0; i < 8; ++i) f[i] = gs == 0 ? lg[4 + i] : (gs == 1 ? lg[12 + i] : (gs == 2 ? lg[20 + i] : lg[28 + i]));
            int i1 = 0; float v1 = f[0];
#pragma unroll
            for (int i = 1; i < 8; ++i) if (f[i] > v1) { v1 = f[i]; i1 = i; }
            int i2 = -1; float v2 = -3.0e38f;
#pragma unroll
            for (int i = 0; i < 8; ++i) if (i != i1 && f[i] > v2) { v2 = f[i]; i2 = i; }
            const float e2 = expf(v2 - v1), w1 = pg / (1.f + e2), w2 = pg * e2 / (1.f + e2);
            const int t = t0 + lane, ea = gs * 8 + i1, eb = gs * 8 + i2;
            const unsigned pa = atomicAdd(&cnt[ea], 1u), pb = atomicAdd(&cnt[eb], 1u);
            ltok[(size_t)ea * T + pa] = t; lw[(size_t)ea * T + pa] = w1;
            ltok[(size_t)eb * T + pb] = t; lw[(size_t)eb * T + pb] = w2;
            epos[t * 2 + 0] = (ea << 16) | (int)pa; epos[t * 2 + 1] = (eb << 16) | (int)pb;
        }
        __syncthreads();
#pragma unroll 1
        for (int r = 0; r < 8; ++r) {
            const int tl = wave * 8 + r, t = t0 + tl;
            const float mu = stats[tl * 2], rstd = stats[tl * 2 + 1];
            const bf16_t* row = yb + (size_t)t * D_MODEL;
#pragma unroll
            for (int j = 0; j < 2; ++j) {
                const int k = j * 512 + lane * 8;
                float v[8]; unpack8(*(const u32x4*)(row + k), v);
                const float4 g0 = *(const float4*)(g + k), g1 = *(const float4*)(g + k + 4), b0 = *(const float4*)(bta + k), b1 = *(const float4*)(bta + k + 4);
                const float gg[8] = {g0.x, g0.y, g0.z, g0.w, g1.x, g1.y, g1.z, g1.w}, bb[8] = {b0.x, b0.y, b0.z, b0.w, b1.x, b1.y, b1.z, b1.w};
#pragma unroll
                for (int e = 0; e < 8; ++e) v[e] = (v[e] - mu) * rstd * gg[e] + bb[e];
                u32x4 o; o.x = pk2(v[0], v[1]); o.y = pk2(v[2], v[3]); o.z = pk2(v[4], v[5]); o.w = pk2(v[6], v[7]);
                *(u32x4*)(xb + (size_t)t * D_MODEL + k) = o;
            }
        }
    }
}

__global__ void __launch_bounds__(NTHREADS, 2) fwd_megakernel(Params p) {
    extern __shared__ __attribute__((aligned(16))) unsigned char lds_raw[];
    float* smem = (float*)lds_raw;
    {
        volatile LAS unsigned* st0 = (volatile LAS unsigned*)(lds_raw + 163824);
        if (threadIdx.x < 2) st0[threadIdx.x] = 0u;
        __syncthreads();
    }
    (void)xcd_barrier_post((unsigned*)(p.ws + WS_CTL) + CW_BAR, (volatile LAS unsigned*)(lds_raw + 163824));
#define GRID_SYNC() do { XcdBarrier gb_; gb_.bar = (unsigned*)(p.ws + WS_CTL) + CW_BAR; gb_.x = xb_xcc_id(); gb_.st = (volatile LAS unsigned*)(lds_raw + 163824); xcd_barrier(gb_); } while (0)
#define RUN(mask, ...) do { __VA_ARGS__; if (PROBE & (mask)) { GRID_SYNC(); __VA_ARGS__; } } while (0)
    RUN(1, ph_prologue(p, lds_raw); ph_router_tables(p));
    GRID_SYNC();
    RUN(2, ph_inproj0_g8(p, lds_raw));
    GRID_SYNC();
    ph_mla_pre(p);
    GRID_SYNC();
    RUN(4, ph_mla_up_g8(p, lds_raw));
    GRID_SYNC();
    RUN(8, ph_attn0_f(p, lds_raw));
    GRID_SYNC();
    RUN(16, ph_outproj0_g8(p, lds_raw));
    GRID_SYNC();
    if (PROBE & 2048) { ph_ln_router_f(p, 0, lds_raw, true); GRID_SYNC(); }
    if (blockIdx.x & 1) { ph_cvt_moe(p, 0, lds_raw); ph_ln_router_f(p, 0, lds_raw); } else { ph_ln_router_f(p, 0, lds_raw); ph_cvt_moe(p, 0, lds_raw); }
    GRID_SYNC();
    RUN(64, ph_moe_up_g8(p, 0, lds_raw));
    GRID_SYNC();
    RUN(128, ph_moe_down_g8(p, 0, lds_raw));
    GRID_SYNC();
    ph_ffn_ln(p, 0, smem, false);
    GRID_SYNC();
    RUN(256, ph_inproj1_g8(p, lds_raw));
    GRID_SYNC();
    RUN(512, ph_dil_f<false>(p, lds_raw));
    GRID_SYNC();
    RUN(1024, ph_dil_f<true>(p, lds_raw));
    GRID_SYNC();
    ph_outproj1_g8(p, lds_raw);
    GRID_SYNC();
    if (blockIdx.x & 1) { ph_cvt_moe(p, 1, lds_raw); ph_ln_router_f(p, 1, lds_raw); } else { ph_ln_router_f(p, 1, lds_raw); ph_cvt_moe(p, 1, lds_raw); }
    GRID_SYNC();
    ph_moe_up_g8(p, 1, lds_raw);
    GRID_SYNC();
    ph_moe_down_g8(p, 1, lds_raw);
    GRID_SYNC();
    ph_ffn_ln(p, 1, smem, true);
}

constexpr size_t LDS_BYTES = 163840;

extern "C" void kernel_launch(void* const* d_in, const int* in_sizes, int n_in, void* d_out, int out_size, void* d_ws, size_t ws_size, hipStream_t stream) {
    static int grid_blocks = 0;
    if (grid_blocks == 0) {
        if (n_in != 25 || ws_size < WS_END) { fprintf(stderr, "kernel_launch: unexpected n_in %d / ws_size %zu (need %zu)\n", n_in, ws_size, (size_t)WS_END); grid_blocks = -1; return; }
        int dev = 0, cus = 0, per_cu = 0;
        hipGetDevice(&dev);
        hipDeviceGetAttribute(&cus, hipDeviceAttributeMultiprocessorCount, dev);
        hipFuncSetAttribute((const void*)fwd_megakernel, hipFuncAttributeMaxDynamicSharedMemorySize, (int)LDS_BYTES);
        hipOccupancyMaxActiveBlocksPerMultiprocessor(&per_cu, (const void*)fwd_megakernel, NTHREADS, LDS_BYTES);
        if (per_cu < 1) { fprintf(stderr, "kernel_launch: occupancy query gave %d\n", per_cu); grid_blocks = -1; return; }
        if (per_cu > 1) per_cu = 1;
        grid_blocks = cus * per_cu;
        fprintf(stderr, "kernel_launch: grid %d (cus %d x %d), ws %zu\n", grid_blocks, cus, per_cu, ws_size);
    }
    if (grid_blocks < 0) return;
    hipMemsetAsync((char*)d_ws + WS_CTL, 0, 1 * MiB, stream);
    Params p{};
    for (int i = 0; i < 25; ++i) p.in[i] = (const float*)d_in[i];
    p.out = (float*)d_out; p.ws = (unsigned char*)d_ws;
    void* args[] = {&p};
    hipError_t e = hipLaunchCooperativeKernel((const void*)fwd_megakernel, dim3(grid_blocks), dim3(NTHREADS), args, LDS_BYTES, stream);
    if (e != hipSuccess) fprintf(stderr, "cooperative launch failed: %s (grid %d)\n", hipGetErrorString(e), grid_blocks);
}
```

```cpp
#include <hip/hip_runtime.h>
#include <hip/hip_cooperative_groups.h>
#include <cstdio>
#include <cstdint>
namespace cg = cooperative_groups;

constexpr int D_MODEL = 1024, BATCH = 8, SEQ = 4096, T = BATCH * SEQ;
constexpr int AB_IN = 1952, H0_LD = 2048, VT_LD = T + 64;
constexpr int MOE_E = 32, MOE_H = 512;
constexpr float ALPHA = 1.4142135623730951f;
constexpr float EPS = 1e-5f;
constexpr int NTHREADS = 512;
#ifndef PROBE
#define PROBE 0
#endif

typedef unsigned short bf16_t;

constexpr size_t MiB = 1ull << 20;
constexpr size_t WS_CTL = 0;
constexpr size_t WS_LTOK = 1 * MiB;
constexpr size_t WS_LW = 5 * MiB;
constexpr size_t WS_EPOS = 9 * MiB;
constexpr size_t WS_RS = 9 * MiB + 256 * 1024;
constexpr size_t WS_RTAB = 9 * MiB + 512 * 1024;
constexpr size_t WS_RCONST = WS_RTAB + 320 * 1024;
constexpr size_t WS_WSMALL = 10 * MiB;
constexpr size_t WT_IN_AB = WS_WSMALL;
constexpr size_t WT_UQ = WT_IN_AB + 4 * MiB;
constexpr size_t WT_UKV = WT_UQ + 256 * 1024;
constexpr size_t WT_OUT_AB = WT_UKV + 256 * 1024;
constexpr size_t WT_IN_C = WT_OUT_AB + 2 * MiB;
constexpr size_t WT_OUT_C = WT_IN_C + 6 * MiB;
constexpr size_t WS_XB = 26 * MiB;
constexpr size_t WS_HBUF = 90 * MiB;
constexpr size_t WS_Q = 282 * MiB;
constexpr size_t WS_END = 491 * MiB;
constexpr size_t HB_YB = 0;
constexpr size_t HB_H = 0;
constexpr size_t HB_Y = 64 * MiB;
constexpr size_t Q_QB = 0;
constexpr size_t Q_KB = 24 * MiB;
constexpr size_t Q_VB = 48 * MiB;
constexpr size_t Q_AO = 80 * MiB;
constexpr size_t Q_VTA = 176 * MiB;
constexpr size_t Q_OPART = 64 * MiB;
constexpr size_t Q_LSE = 192 * MiB;
constexpr size_t HB_AOC = 128 * MiB;
constexpr size_t Q_O1 = 0;
constexpr int CW_CNT = 1024, CNT_PAD = 32;

struct Params {
    const float* in[25];
    float* out;
    unsigned char* ws;
};

__device__ __forceinline__ bf16_t f2bf(float f) { unsigned u = __float_as_uint(f); u += 0x7fffu + ((u >> 16) & 1u); return (bf16_t)(u >> 16); }
__device__ __forceinline__ float bf2f(bf16_t h) { return __uint_as_float(((unsigned)h) << 16); }
#define WS_DPP(v, ctrl) __int_as_float(__builtin_amdgcn_update_dpp(0, __float_as_int(v), (ctrl), 0xF, 0xF, true))
__device__ __forceinline__ float wave_sum(float v) {
    v += WS_DPP(v, 0xB1);
    v += WS_DPP(v, 0x4E);
    v += WS_DPP(v, 0x141);
    v += WS_DPP(v, 0x140);
    { auto t_ = __builtin_amdgcn_permlane16_swap(__float_as_uint(v), __float_as_uint(v), false, false); v = __uint_as_float(t_[0]) + __uint_as_float(t_[1]); }
    { auto t_ = __builtin_amdgcn_permlane32_swap(__float_as_uint(v), __float_as_uint(v), false, false); v = __uint_as_float(t_[0]) + __uint_as_float(t_[1]); }
    return v;
}
__device__ __forceinline__ float xor32_max(float x) {
    auto t_ = __builtin_amdgcn_permlane32_swap(__float_as_uint(x), __float_as_uint(x), false, false);
    float r; asm("v_max_f32_e32 %0, %1, %2" : "=v"(r) : "v"(__uint_as_float(t_[0])), "v"(__uint_as_float(t_[1]))); return r;
}

__device__ __forceinline__ int thr() { int t = threadIdx.x; asm volatile("" : "+v"(t)); return t; }
__device__ __forceinline__ int xcd_item(int k) { const int G = gridDim.x, bid = blockIdx.x; if (G & 7) return bid + k * G; const int J = G >> 3; return (k * 8 + (bid & 7)) * J + (bid >> 3); }
typedef short bf16x8 __attribute__((ext_vector_type(8)));
typedef float f32x16 __attribute__((ext_vector_type(16)));
typedef unsigned u32x4 __attribute__((ext_vector_type(4)));
typedef __bf16 bf16x2_t __attribute__((ext_vector_type(2)));
typedef float f32x2_t __attribute__((ext_vector_type(2)));
__device__ __forceinline__ unsigned pk2(float lo, float hi) { f32x2_t v = {lo, hi}; return __builtin_bit_cast(unsigned, __builtin_convertvector(v, bf16x2_t)); }
#define MFMA32(a, b, c) __builtin_amdgcn_mfma_f32_32x32x16_bf16((a), (b), (c), 0, 0, 0)
__device__ __forceinline__ float max3_s(float a, float b, float c) { float r; asm("v_max3_f32 %0, %1, %2, %3" : "=v"(r) : "v"(a), "v"(b), "v"(c)); return r; }
__device__ __forceinline__ void unpack8(const u32x4& v, float (&f)[8]) {
    f[0] = __uint_as_float(v.x << 16); f[1] = __uint_as_float(v.x & 0xffff0000u); f[2] = __uint_as_float(v.y << 16); f[3] = __uint_as_float(v.y & 0xffff0000u);
    f[4] = __uint_as_float(v.z << 16); f[5] = __uint_as_float(v.z & 0xffff0000u); f[6] = __uint_as_float(v.w << 16); f[7] = __uint_as_float(v.w & 0xffff0000u);
}

__device__ __forceinline__ int swz128(int row, int chunk) { return row * 128 + ((chunk ^ ((row >> 1) & 7)) << 4); }
namespace g8 {
#define G8_LAS __attribute__((address_space(3)))
typedef float f32x4 __attribute__((ext_vector_type(4)));
constexpr int BM = 256, BK = 64, HALF = 128, HTB = HALF * BK * 2, RING = 8 * HTB;
__device__ __forceinline__ int lds_byte(int r, int c) { const int st = (r >> 4) * 2 + (c >> 5), rr = r & 15, cc = c & 31, ob = rr * 64 + cc * 2; return st * 1024 + (ob ^ (((ob >> 9) & 1) << 5)); }
__device__ __forceinline__ void stage_rc(int b, int& R, int& C) { const int st = b / 1024, sb = b % 1024, swz = sb ^ (((sb >> 9) & 1) << 5); R = (st >> 1) * 16 + swz / 64; C = (st & 1) * 32 + (swz % 64) / 2; }
__device__ __forceinline__ int perm32(int rho) { const int n = rho >> 4, i = rho & 15; return 8 * (i >> 2) + 4 * n + (i & 3); }
struct Unit { const char* a; const char* b; int r0, c0, x0, x1, x2, x3; };

template <class Epi, class Sched>
__device__ __forceinline__ void gemm_phase(G8_LAS unsigned char* lds, int K, int ldb, const Sched& S, const Epi& E) {
    const int tid = thr(), wid = __builtin_amdgcn_readfirstlane(tid >> 6), lane = tid & 63, wr = wid >> 2, wc = wid & 3, fr = lane & 15, fq = lane >> 4;
    asm volatile("" : "+s"(K));
    const int nt = K / BK;
    int Rr[2], Cc[2]; unsigned voffB[2];
#pragma unroll
    for (int i = 0; i < 2; ++i) { stage_rc(tid * 16 + i * 8192, Rr[i], Cc[i]); const int Rb = (Rr[i] & ~31) + perm32(Rr[i] & 31); voffB[i] = (unsigned)(Rb * ldb + Cc[i]) * 2u; }
    const size_t kstep = (size_t)(BK * 2);
    const size_t hstepB = (size_t)HALF * ldb * 2;
    const unsigned ldsw = (unsigned)wid * 1024u;
    const int aoff = lds_byte(wr * 64 + fr, fq * 8), boff = lds_byte(wc * 32 + fr, fq * 8);
#define G8_SA(b, h) (((b) * 2 + (h)) * HTB)
#define G8_SB(b, h) ((4 + (b) * 2 + (h)) * HTB)
#define G8_STAGE_B(bufoff, gbase) do { _Pragma("unroll") for (int _i = 0; _i < 2; ++_i) \
        __builtin_amdgcn_global_load_lds((const unsigned*)((const char*)(gbase) + voffB[_i]), (G8_LAS unsigned*)(lds + (bufoff) + ldsw + _i * 8192), 16, 0, 0); } while (0)
#define G8_STAGE_A(bufoff, gbase, offs) do { _Pragma("unroll") for (int _i = 0; _i < 2; ++_i) \
        __builtin_amdgcn_global_load_lds((const unsigned*)((const char*)(gbase) + (offs)[_i]), (G8_LAS unsigned*)(lds + (bufoff) + ldsw + _i * 8192), 16, 0, 0); } while (0)
#define G8_LDA(dst, b, h) do { _Pragma("unroll") for (int m = 0; m < 4; ++m) _Pragma("unroll") for (int k = 0; k < 2; ++k) dst[m][k] = *(const G8_LAS bf16x8*)(lds + G8_SA(b, h) + aoff + m * 2048 + k * 1024); } while (0)
#define G8_LDB(dst, b, h) do { _Pragma("unroll") for (int n = 0; n < 2; ++n) _Pragma("unroll") for (int k = 0; k < 2; ++k) dst[n][k] = *(const G8_LAS bf16x8*)(lds + G8_SB(b, h) + boff + n * 2048 + k * 1024); } while (0)
#define G8_MMA(ai, bj, At, Bt) do { __builtin_amdgcn_s_setprio(1); _Pragma("unroll") for (int m = 0; m < 4; ++m) _Pragma("unroll") for (int n = 0; n < 2; ++n) _Pragma("unroll") for (int k = 0; k < 2; ++k) \
        acc[ai][bj][m][n] = __builtin_amdgcn_mfma_f32_16x16x32_bf16(Bt[n][k], At[m][k], acc[ai][bj][m][n], 0, 0, 0); __builtin_amdgcn_s_setprio(0); } while (0)
#define G8_WAIT_V(n) asm volatile("s_waitcnt vmcnt(" #n ")" ::: "memory")
#define G8_WAIT_L(n) asm volatile("s_waitcnt lgkmcnt(" #n ")" ::: "memory")
#define G8_BAR __builtin_amdgcn_s_barrier()
#define G8_SCHED __builtin_amdgcn_sched_barrier(0)
    Unit cur, nxt; int ui = 0;
    if (!S.next(0, cur)) return;
    f32x4 acc[2][2][4][2];
#pragma unroll
    for (int a = 0; a < 2; ++a)
#pragma unroll
        for (int b = 0; b < 2; ++b)
#pragma unroll
            for (int m = 0; m < 4; ++m)
#pragma unroll
                for (int n = 0; n < 2; ++n) acc[a][b][m][n] = (f32x4){0.f, 0.f, 0.f, 0.f};
    bf16x8 At[4][2], B0[2][2], B1[2][2];
    unsigned ac[2][2], an[2][2];
#pragma unroll
    for (int h = 0; h < 2; ++h)
#pragma unroll
        for (int i = 0; i < 2; ++i) ac[h][i] = S.a_off(cur, 128 * h + Rr[i]) + (unsigned)Cc[i] * 2u;
    const char* cA = cur.a; const char* cB = cur.b;
    G8_BAR;
    G8_STAGE_B(G8_SB(0, 0), cB); G8_STAGE_B(G8_SB(0, 1), cB + hstepB); G8_STAGE_A(G8_SA(0, 0), cA, ac[0]); G8_STAGE_A(G8_SA(0, 1), cA, ac[1]);
    if (wr == 1) G8_BAR;
    G8_WAIT_V(2); G8_BAR;
    G8_STAGE_B(G8_SB(1, 0), cB + kstep); G8_STAGE_A(G8_SA(1, 0), cA + kstep, ac[0]); G8_STAGE_B(G8_SB(1, 1), cB + hstepB + kstep);
    G8_WAIT_V(6); G8_BAR;
    for (;;) {
        const bool has_next = S.next(ui + 1, nxt);
        const char* nA = has_next ? nxt.a : cA; const char* nB = has_next ? nxt.b : cB;
#pragma unroll
        for (int h = 0; h < 2; ++h)
#pragma unroll
            for (int i = 0; i < 2; ++i) an[h][i] = has_next ? S.a_off(nxt, 128 * h + Rr[i]) + (unsigned)Cc[i] * 2u : ac[h][i];
#pragma unroll 1
        for (int t = 0; t < nt; t += 2) {
            const bool last = (t == nt - 2);
            const char* a1 = cA + (size_t)(t + 1) * kstep;
            const char* a2 = last ? nA : cA + (size_t)(t + 2) * kstep; const char* b2 = last ? nB : cB + (size_t)(t + 2) * kstep;
            const char* a3 = a2 + kstep; const char* b3 = b2 + kstep;
            unsigned a2o[2][2];
#pragma unroll
            for (int h = 0; h < 2; ++h)
#pragma unroll
                for (int i = 0; i < 2; ++i) a2o[h][i] = last ? an[h][i] : ac[h][i];
            G8_LDB(B0, 0, 0); G8_LDB(B1, 0, 1); G8_SCHED; G8_LDA(At, 0, 0); G8_STAGE_A(G8_SA(1, 1), a1, ac[1]);
            G8_WAIT_V(8); G8_WAIT_L(0); G8_BAR; G8_MMA(0, 0, At, B0); G8_MMA(0, 1, At, B1); G8_BAR; G8_SCHED;
            G8_LDA(At, 0, 1); G8_STAGE_B(G8_SB(0, 0), b2); G8_STAGE_B(G8_SB(0, 1), b2 + hstepB); G8_STAGE_A(G8_SA(0, 0), a2, a2o[0]);
            G8_WAIT_V(8); G8_WAIT_L(0); G8_BAR; G8_MMA(1, 0, At, B0); G8_MMA(1, 1, At, B1); G8_BAR; G8_SCHED;
            G8_LDB(B0, 1, 0); G8_LDB(B1, 1, 1); G8_SCHED; G8_LDA(At, 1, 0); G8_STAGE_A(G8_SA(0, 1), a2, a2o[1]);
            G8_WAIT_V(8); G8_WAIT_L(0); G8_BAR; G8_MMA(0, 0, At, B0); G8_MMA(0, 1, At, B1); G8_BAR; G8_SCHED;
            G8_LDA(At, 1, 1); G8_STAGE_B(G8_SB(1, 0), b3); G8_STAGE_B(G8_SB(1, 1), b3 + hstepB); G8_STAGE_A(G8_SA(1, 0), a3, a2o[0]);
            G8_WAIT_V(8); G8_WAIT_L(0); G8_BAR; G8_MMA(1, 0, At, B0); G8_MMA(1, 1, At, B1); G8_BAR; G8_SCHED;
        }
        if (wr == 0) G8_BAR;
        E(acc, cur, wr, wc, fr, fq);
        if (!has_next) break;
#pragma unroll
        for (int a = 0; a < 2; ++a)
#pragma unroll
            for (int b = 0; b < 2; ++b)
#pragma unroll
                for (int m = 0; m < 4; ++m)
#pragma unroll
                    for (int n = 0; n < 2; ++n) acc[a][b][m][n] = (f32x4){0.f, 0.f, 0.f, 0.f};
        cur = nxt; cA = nA; cB = nB; ++ui;
#pragma unroll
        for (int h = 0; h < 2; ++h)
#pragma unroll
            for (int i = 0; i < 2; ++i) ac[h][i] = an[h][i];
        if (wr == 1) G8_BAR;
    }
    G8_WAIT_V(0);
    G8_BAR;
#undef G8_SA
#undef G8_SB
#undef G8_STAGE_A
#undef G8_STAGE_B
#undef G8_LDA
#undef G8_LDB
#undef G8_MMA
#undef G8_WAIT_V
#undef G8_WAIT_L
#undef G8_BAR
#undef G8_SCHED
}

template <bool UP, class Sched>
__device__ __forceinline__ void gemm_quarter_moe(G8_LAS unsigned char* lds, int K, int ldb, const Sched& S, int ubase, int nq, bf16_t* Out, const float* lw) {
    const int tid = thr(), wid = __builtin_amdgcn_readfirstlane(tid >> 6), lane = tid & 63, wr = wid >> 2, wc = wid & 3, fr = lane & 15, fq = lane >> 4;
    asm volatile("" : "+s"(K));
    const int nt = K / BK;
    int Rr[2], Cc[2];
#pragma unroll
    for (int i = 0; i < 2; ++i) stage_rc(tid * 16 + i * 8192, Rr[i], Cc[i]);
    const unsigned ldsw = (unsigned)wid * 1024u;
    const int aoff = lds_byte(wr * 64 + fr, fq * 8), boff = lds_byte(wc * 32 + fr, fq * 8);
#define GQ_STAGE(st, kt) do { _Pragma("unroll") for (int _i = 0; _i < 2; ++_i) { \
        __builtin_amdgcn_global_load_lds((const unsigned*)(u.a + (size_t)(kt) * (BK * 2) + ao[_i]), (G8_LAS unsigned*)(lds + (st) * (2 * HTB) + ldsw + _i * 8192), 16, 0, 0); \
        __builtin_amdgcn_global_load_lds((const unsigned*)(u.b + (size_t)(kt) * (BK * 2) + bo[_i]), (G8_LAS unsigned*)(lds + (st) * (2 * HTB) + HTB + ldsw + _i * 8192), 16, 0, 0); } } while (0)
    for (int k = 0;; ++k) {
        const int qi = xcd_item(k);
        if (qi >= nq) break;
        Unit u; S.unit(ubase + (qi >> 2), u);
        const int ah = (qi >> 1) & 1, ch = qi & 1;
        unsigned ao[2], bo[2];
#pragma unroll
        for (int i = 0; i < 2; ++i) {
            ao[i] = S.a_off(u, 128 * ah + Rr[i]) + (unsigned)Cc[i] * 2u;
            const int c = (Rr[i] & ~31) + perm32(Rr[i] & 31);
            const int wrow = UP ? 128 * ((c >> 2) & 1) + 64 * ch + 16 * (c >> 5) + 4 * ((c >> 3) & 3) + (c & 3) : 128 * ch + c;
            bo[i] = (unsigned)(wrow * ldb + Cc[i]) * 2u;
        }
        f32x4 acc[4][2];
#pragma unroll
        for (int m = 0; m < 4; ++m)
#pragma unroll
            for (int n = 0; n < 2; ++n) acc[m][n] = (f32x4){0.f, 0.f, 0.f, 0.f};
        GQ_STAGE(0, 0); GQ_STAGE(1, 1); GQ_STAGE(2, 2);
#pragma unroll 1
        for (int t0 = 0; t0 < nt; t0 += 4) {
#pragma unroll
            for (int s4 = 0; s4 < 4; ++s4) {
                const int t = t0 + s4;
                if (t + 2 < nt) asm volatile("s_waitcnt vmcnt(8)" ::: "memory"); else if (t + 1 < nt) asm volatile("s_waitcnt vmcnt(4)" ::: "memory"); else asm volatile("s_waitcnt vmcnt(0)" ::: "memory");
                __builtin_amdgcn_s_barrier();
                if (t + 3 < nt) GQ_STAGE((s4 + 3) & 3, t + 3);
                bf16x8 At[4][2], Bq[2][2];
#pragma unroll
                for (int m = 0; m < 4; ++m)
#pragma unroll
                    for (int kk = 0; kk < 2; ++kk) At[m][kk] = *(const G8_LAS bf16x8*)(lds + s4 * (2 * HTB) + aoff + m * 2048 + kk * 1024);
#pragma unroll
                for (int n = 0; n < 2; ++n)
#pragma unroll
                    for (int kk = 0; kk < 2; ++kk) Bq[n][kk] = *(const G8_LAS bf16x8*)(lds + s4 * (2 * HTB) + HTB + boff + n * 2048 + kk * 1024);
                asm volatile("s_waitcnt lgkmcnt(0)" ::: "memory");
#pragma unroll
                for (int m = 0; m < 4; ++m)
#pragma unroll
                    for (int n = 0; n < 2; ++n)
#pragma unroll
                        for (int kk = 0; kk < 2; ++kk) acc[m][n] = __builtin_amdgcn_mfma_f32_16x16x32_bf16(Bq[n][kk], At[m][kk], acc[m][n], 0, 0, 0);
            }
        }
        if (UP) {
#pragma unroll
            for (int m = 0; m < 4; ++m) {
                const int row = 128 * ah + 64 * wr + 16 * m + fr;
                if (row < u.x1) {
                    float hv[4];
#pragma unroll
                    for (int e = 0; e < 4; ++e) { const float g = acc[m][0][e]; hv[e] = g * __builtin_amdgcn_rcpf(1.f + __builtin_amdgcn_exp2f(-1.4426950408889634f * g)) * acc[m][1][e]; }
                    uint2 w; w.x = pk2(hv[0], hv[1]); w.y = pk2(hv[2], hv[3]);
                    *(uint2*)(Out + (size_t)(u.r0 + row) * MOE_H + (u.c0 >> 1) + 64 * ch + 16 * wc + 4 * fq) = w;
                }
            }
        } else {
            const float* lwp = lw + (size_t)u.x0 * T + u.x2;
            float wg4[4];
#pragma unroll
            for (int m = 0; m < 4; ++m) wg4[m] = lwp[min(128 * ah + 64 * wr + 16 * m + fr, u.x1 - 1)];
#pragma unroll
            for (int m = 0; m < 4; ++m) {
                const int row = 128 * ah + 64 * wr + 16 * m + fr;
                if (row < u.x1) {
                    const float wgt = wg4[m];
                    const f32x4 v0 = acc[m][0], v1 = acc[m][1];
                    u32x4 w; w.x = pk2(v0[0] * wgt, v0[1] * wgt); w.y = pk2(v0[2] * wgt, v0[3] * wgt); w.z = pk2(v1[0] * wgt, v1[1] * wgt); w.w = pk2(v1[2] * wgt, v1[3] * wgt);
                    *(u32x4*)(Out + (size_t)(u.r0 + row) * D_MODEL + u.c0 + 128 * ch + 32 * wc + 8 * fq) = w;
                }
            }
        }
    }
    asm volatile("s_waitcnt vmcnt(0)" ::: "memory");
    __builtin_amdgcn_s_barrier();
#undef GQ_STAGE
}
}

struct SchedDense {
    const char* A; const char* B; int lda2, ldb2, nN, nunits, skip_lo, skip_hi;
    __device__ __forceinline__ bool next(int i, g8::Unit& u) const {
        const int L = xcd_item(i); if (L >= nunits) return false;
        const int nNe = nN - (skip_hi - skip_lo), pm = L / nNe; int pn = L % nNe; if (pn >= skip_lo) pn += skip_hi - skip_lo;
        u.a = A + (size_t)pm * 256 * lda2; u.b = B + (size_t)pn * 256 * ldb2; u.r0 = pm * 256; u.c0 = pn * 256; u.x0 = 0; u.x1 = 0; u.x2 = 0; u.x3 = 0; return true;
    }
    __device__ __forceinline__ unsigned a_off(const g8::Unit&, int row) const { return (unsigned)row * (unsigned)lda2; }
};
struct EpiRowBf16 {
    bf16_t* O; int ld, N;
    __device__ __forceinline__ void operator()(const g8::f32x4 (&acc)[2][2][4][2], const g8::Unit& u, int wr, int wc, int fr, int fq) const {
#pragma unroll
        for (int ai = 0; ai < 2; ++ai)
#pragma unroll
            for (int m = 0; m < 4; ++m) {
                bf16_t* rowp = O + (size_t)(u.r0 + 128 * ai + 64 * wr + 16 * m + fr) * ld + u.c0 + 32 * wc + 8 * fq;
#pragma unroll
                for (int bj = 0; bj < 2; ++bj) {
                    if (u.c0 + 128 * bj + 32 * wc + 8 * fq < N) {
                        const g8::f32x4 v0 = acc[ai][bj][m][0], v1 = acc[ai][bj][m][1];
                        u32x4 w; w.x = pk2(v0[0], v0[1]); w.y = pk2(v0[2], v0[3]); w.z = pk2(v1[0], v1[1]); w.w = pk2(v1[2], v1[3]);
                        *(u32x4*)(rowp + 128 * bj) = w;
                    }
                }
            }
    }
};

template <bool SRC_F32>
struct EpiResidualBf16 {
    const void* src; bf16_t* dst;
    __device__ __forceinline__ void operator()(const g8::f32x4 (&acc)[2][2][4][2], const g8::Unit& u, int wr, int wc, int fr, int fq) const {
#pragma unroll
        for (int ai = 0; ai < 2; ++ai)
#pragma unroll
            for (int m = 0; m < 4; ++m) {
                const size_t ro = (size_t)(u.r0 + 128 * ai + 64 * wr + 16 * m + fr) * D_MODEL + u.c0 + 32 * wc + 8 * fq;
#pragma unroll
                for (int bj = 0; bj < 2; ++bj) {
                    float r[8];
                    if (SRC_F32) {
                        const float4 a = *(const float4*)((const float*)src + ro + 128 * bj), b = *(const float4*)((const float*)src + ro + 128 * bj + 4);
                        r[0] = a.x; r[1] = a.y; r[2] = a.z; r[3] = a.w; r[4] = b.x; r[5] = b.y; r[6] = b.z; r[7] = b.w;
                    } else unpack8(*(const u32x4*)((const bf16_t*)src + ro + 128 * bj), r);
                    const g8::f32x4 v0 = acc[ai][bj][m][0], v1 = acc[ai][bj][m][1];
                    u32x4 w;
                    w.x = pk2(ALPHA * r[0] + v0[0], ALPHA * r[1] + v0[1]); w.y = pk2(ALPHA * r[2] + v0[2], ALPHA * r[3] + v0[3]);
                    w.z = pk2(ALPHA * r[4] + v1[0], ALPHA * r[5] + v1[1]); w.w = pk2(ALPHA * r[6] + v1[2], ALPHA * r[7] + v1[3]);
                    *(u32x4*)(dst + ro + 128 * bj) = w;
                }
            }
    }
};


template <bool UP>
struct SchedMoe {
    const char* A; const char* B; int ldb2; size_t bstride; const int* sbase; const int* stile; const int* ltok; int ulimit;
    __device__ __forceinline__ bool next(int i, g8::Unit& u) const {
        const int L = xcd_item(i);
        if (L >= ulimit) return false;
        unit(L, u); return true;
    }
    __device__ __forceinline__ void unit(int L, g8::Unit& u) const {
        const int tile = L >> 2, pn = L & 3;
        int e = 0;
#pragma unroll
        for (int sstep = 16; sstep >= 1; sstep >>= 1) if (stile[e + sstep] <= tile) e += sstep;
        const int tr0 = (tile - stile[e]) * 256, cnt = sbase[e + 1] - sbase[e];
        u.b = B + (size_t)e * bstride + (size_t)pn * 256 * ldb2;
        u.r0 = sbase[e] + tr0; u.c0 = pn * 256; u.x0 = e; u.x1 = min(256, cnt - tr0); u.x2 = tr0; u.x3 = cnt;
        u.a = UP ? A : A + (size_t)u.r0 * (MOE_H * 2);
    }
    __device__ __forceinline__ unsigned a_off(const g8::Unit& u, int row) const {
        if (UP) return (unsigned)ltok[(size_t)u.x0 * T + min(u.x2 + row, u.x3 - 1)] * (unsigned)(D_MODEL * 2);
        return (unsigned)row * (unsigned)(MOE_H * 2);
    }
};
struct EpiMoeUp {
    bf16_t* H;
    __device__ __forceinline__ void operator()(const g8::f32x4 (&acc)[2][2][4][2], const g8::Unit& u, int wr, int wc, int fr, int fq) const {
#pragma unroll
        for (int ai = 0; ai < 2; ++ai)
#pragma unroll
            for (int m = 0; m < 4; ++m) {
                const int row = 128 * ai + 64 * wr + 16 * m + fr;
                if (row < u.x1) {
                    float hv[8];
#pragma unroll
                    for (int n = 0; n < 2; ++n)
#pragma unroll
                        for (int e = 0; e < 4; ++e) { const float g = acc[ai][0][m][n][e]; hv[4 * n + e] = g * __builtin_amdgcn_rcpf(1.f + __builtin_amdgcn_exp2f(-1.4426950408889634f * g)) * acc[ai][1][m][n][e]; }
                    u32x4 w; w.x = pk2(hv[0], hv[1]); w.y = pk2(hv[2], hv[3]); w.z = pk2(hv[4], hv[5]); w.w = pk2(hv[6], hv[7]);
                    *(u32x4*)(H + (size_t)(u.r0 + row) * MOE_H + (u.c0 >> 1) + 32 * wc + 8 * fq) = w;
                }
            }
    }
};
struct EpiMoeDown {
    bf16_t* Y; const float* lw;
    __device__ __forceinline__ void operator()(const g8::f32x4 (&acc)[2][2][4][2], const g8::Unit& u, int wr, int wc, int fr, int fq) const {
#pragma unroll
        for (int ai = 0; ai < 2; ++ai) {
            const float* lwp = lw + (size_t)u.x0 * T + u.x2;
            float wg4[4];
#pragma unroll
            for (int m = 0; m < 4; ++m) wg4[m] = lwp[min(128 * ai + 64 * wr + 16 * m + fr, u.x1 - 1)];
            asm volatile("" : "+v"(wg4[0]), "+v"(wg4[1]), "+v"(wg4[2]), "+v"(wg4[3]));
#pragma unroll
            for (int m = 0; m < 4; ++m) {
                const int row = 128 * ai + 64 * wr + 16 * m + fr;
                if (row < u.x1) {
                    const float wgt = wg4[m];
                    bf16_t* rowp = Y + (size_t)(u.r0 + row) * D_MODEL + u.c0 + 32 * wc + 8 * fq;
#pragma unroll
                    for (int bj = 0; bj < 2; ++bj) {
                        const g8::f32x4 v0 = acc[ai][bj][m][0], v1 = acc[ai][bj][m][1];
                        u32x4 w; w.x = pk2(v0[0] * wgt, v0[1] * wgt); w.y = pk2(v0[2] * wgt, v0[3] * wgt); w.z = pk2(v1[0] * wgt, v1[1] * wgt); w.w = pk2(v1[2] * wgt, v1[3] * wgt);
                        *(u32x4*)(rowp + 128 * bj) = w;
                    }
                }
            }
        }
    }
};

template <class RM, class KS>
__device__ __forceinline__ void cvt_w_tile(const float* __restrict__ W, int K, int N, int ntn, bf16_t* Wt, int tile, RM rowmap, KS kscale, bf16_t* sT) {
    const int tid = thr();
    const int tk = tile / ntn, tn = tile % ntn, k0 = tk * 64, n0 = tn * 64;
    __syncthreads();
#pragma unroll
    for (int it = 0; it < 2; ++it) {
        const int kk = (tid >> 4) + 32 * it, n4 = (tid & 15) * 4;
        float4 v = make_float4(0.f, 0.f, 0.f, 0.f);
        if (n0 + n4 < N) v = *(const float4*)(W + (size_t)(k0 + kk) * N + n0 + n4);
        const float sc = kscale(k0 + kk);
        sT[(n4 + 0) * 72 + kk] = f2bf(v.x * sc); sT[(n4 + 1) * 72 + kk] = f2bf(v.y * sc);
        sT[(n4 + 2) * 72 + kk] = f2bf(v.z * sc); sT[(n4 + 3) * 72 + kk] = f2bf(v.w * sc);
    }
    __syncthreads();
    const int n = tid >> 3, kq = (tid & 7) * 8;
    const u32x4 a = *(const u32x4*)(sT + n * 72 + kq);
    *(u32x4*)(Wt + (size_t)rowmap(n0 + n) * K + k0 + kq) = a;
}

__device__ __forceinline__ void ph_cvt_x(const Params& p) {
    const float4* x = (const float4*)p.in[0];
    uint2* xb = (uint2*)(p.ws + WS_XB);
    const size_t n4 = (size_t)T * D_MODEL / 4;
    for (size_t i = (size_t)blockIdx.x * NTHREADS + thr(); i < n4; i += (size_t)gridDim.x * NTHREADS) {
        const float4 v = x[i];
        uint2 o; o.x = f2bf(v.x) | ((unsigned)f2bf(v.y) << 16); o.y = f2bf(v.z) | ((unsigned)f2bf(v.w) << 16);
        xb[i] = o;
    }
}

__device__ const float ROPE_INV[16] = {1.000000000e+00f, 5.623413324e-01f, 3.162277639e-01f, 1.778279394e-01f, 1.000000015e-01f, 5.623413250e-02f, 3.162277490e-02f, 1.778279431e-02f,
                                       9.999999776e-03f, 5.623413250e-03f, 3.162277630e-03f, 1.778279431e-03f, 1.000000047e-03f, 5.623413017e-04f, 3.162277571e-04f, 1.778279402e-04f};
__device__ __forceinline__ void rope_cs(int s, int i, float& c, float& sn) {
    const float ang = (float)s * ROPE_INV[i];
    const double rev = (double)ang * 0.15915494309189535;
    const float fr = (float)(rev - __builtin_rint(rev));
    c = __builtin_amdgcn_cosf(fr); sn = __builtin_amdgcn_sinf(fr);
}
__device__ __forceinline__ void moe_prefix(const Params& p, int layer, int* sbase, int* stile) {
    __syncthreads();
    const int tid = thr();
    if (tid < 64) {
        const unsigned* cnt = (const unsigned*)(p.ws + WS_CTL) + CW_CNT + layer * 32 * CNT_PAD;
        const int e = tid & 31;
        const int c = tid < 32 ? (int)__hip_atomic_load(cnt + e * CNT_PAD, __ATOMIC_RELAXED, __HIP_MEMORY_SCOPE_AGENT) : 0;
        const int tl = (c + 255) >> 8;
        int bs = c, ts = tl;
#pragma unroll
        for (int d = 1; d < 32; d <<= 1) { const int ob = __shfl_up(bs, d), ot = __shfl_up(ts, d); if (tid >= d) { bs += ob; ts += ot; } }
        if (tid < 32) { sbase[e] = bs - c; stile[e] = ts - tl; }
        if (tid == 31) { sbase[32] = bs; stile[32] = ts; }
    }
    __syncthreads();
}
__device__ __forceinline__ void ph_ffn_ln(const Params& p, int layer, float* smem, bool final_layer) {
    const float* g = p.in[23] + layer * D_MODEL; const float* bta = p.in[24] + layer * D_MODEL;
    const bf16_t* Y = (const bf16_t*)(p.ws + WS_HBUF + HB_Y);
    const int* epos = (const int*)(p.ws + WS_EPOS);
    bf16_t* xb = (bf16_t*)(p.ws + WS_XB);
    int* sbase = (int*)smem; int* stile = sbase + 40;
    moe_prefix(p, layer, sbase, stile);
    const int tid_ = thr(), lane = tid_ & 63, gw = (blockIdx.x * NTHREADS + tid_) >> 6, ngw = (gridDim.x * NTHREADS) >> 6;
    for (int t = gw; t < T; t += ngw) {
        const int ep0 = epos[t * 2], ep1 = epos[t * 2 + 1];
        const size_t s0 = (size_t)(sbase[ep0 >> 16] + (ep0 & 0xffff)), s1 = (size_t)(sbase[ep1 >> 16] + (ep1 & 0xffff));
        float v[2][8]; float s = 0.f;
#pragma unroll
        for (int j = 0; j < 2; ++j) {
            const int k = j * 512 + lane * 8;
            float xa[8], ya[8], yb[8];
            unpack8(*(const u32x4*)(xb + (size_t)t * D_MODEL + k), xa);
            unpack8(*(const u32x4*)(Y + s0 * D_MODEL + k), ya); unpack8(*(const u32x4*)(Y + s1 * D_MODEL + k), yb);
#pragma unroll
            for (int e = 0; e < 8; ++e) { v[j][e] = ALPHA * xa[e] + (ya[e] + yb[e]); s += v[j][e]; }
        }
        const float mu = wave_sum(s) * (1.f / D_MODEL);
        float s2 = 0.f;
#pragma unroll
        for (int j = 0; j < 2; ++j)
#pragma unroll
            for (int e = 0; e < 8; ++e) { v[j][e] -= mu; s2 += v[j][e] * v[j][e]; }
        const float rstd = rsqrtf(wave_sum(s2) * (1.f / D_MODEL) + EPS);
#pragma unroll
        for (int j = 0; j < 2; ++j) {
            const int k = j * 512 + lane * 8;
            const float4 g0 = *(const float4*)(g + k), g1 = *(const float4*)(g + k + 4), b0 = *(const float4*)(bta + k), b1 = *(const float4*)(bta + k + 4);
            const float gg[8] = {g0.x, g0.y, g0.z, g0.w, g1.x, g1.y, g1.z, g1.w}, bb[8] = {b0.x, b0.y, b0.z, b0.w, b1.x, b1.y, b1.z, b1.w};
            float o[8];
#pragma unroll
            for (int e = 0; e < 8; ++e) o[e] = v[j][e] * rstd * gg[e] + bb[e];
            if (final_layer) {
                *(float4*)(p.out + (size_t)t * D_MODEL + k) = make_float4(o[0], o[1], o[2], o[3]);
                *(float4*)(p.out + (size_t)t * D_MODEL + k + 4) = make_float4(o[4], o[5], o[6], o[7]);
            } else {
                u32x4 w; w.x = pk2(o[0], o[1]); w.y = pk2(o[2], o[3]); w.z = pk2(o[4], o[5]); w.w = pk2(o[6], o[7]);
                *(u32x4*)(xb + (size_t)t * D_MODEL + k) = w;
            }
        }
    }
}

__device__ __forceinline__ void ph_prologue(const Params& p, unsigned char* lds) {
    ph_cvt_x(p);
    bf16_t* sT = (bf16_t*)lds;
    unsigned char* ws = p.ws;
    const float* qg = p.in[7]; const float* kvg = p.in[9]; const float* dg = p.in[6];
    constexpr int T0 = 16 * 32, T1 = T0 + 4 * 8, T2 = T1 + 2 * 12, T3 = T2 + 16 * 16, T4 = T3 + 16 * 48, T5 = T4 + 16 * 16;
    auto ident = [](int n) { return n; };
    auto one = [](int) { return 1.f; };
    for (int it = blockIdx.x; it < T5; it += gridDim.x) {
        if (it < T0) cvt_w_tile(p.in[1], 1024, AB_IN, 32, (bf16_t*)(ws + WT_IN_AB), it, ident, one, sT);
        else if (it < T1) cvt_w_tile(p.in[8], 256, 384, 8, (bf16_t*)(ws + WT_UQ), it - T0, ident, [&](int k) { return qg[k]; }, sT);
        else if (it < T2) cvt_w_tile(p.in[10], 128, 768, 12, (bf16_t*)(ws + WT_UKV), it - T1,
                                     [](int n) { const int h = n / 192, i = n % 192; return i < 64 ? h * 64 + i : 256 + h * 128 + (i - 64); }, [&](int k) { return kvg[k]; }, sT);
        else if (it < T3) cvt_w_tile(p.in[11], 1024, 1024, 16, (bf16_t*)(ws + WT_OUT_AB), it - T2, ident, [&](int k) { return k < 512 ? dg[k & 127] * 0.8f : 1.f; }, sT);
        else if (it < T4) cvt_w_tile(p.in[12], 1024, 3072, 48, (bf16_t*)(ws + WT_IN_C), it - T3, ident, one, sT);
        else cvt_w_tile(p.in[13], 1024, 1024, 16, (bf16_t*)(ws + WT_OUT_C), it - T4, ident, one, sT);
    }
}

__device__ __forceinline__ void ph_inproj1_g8(const Params& p, unsigned char* lds) {
    SchedDense S{(const char*)(p.ws + WS_XB), (const char*)(p.ws + WT_IN_C), D_MODEL * 2, D_MODEL * 2, 12, (T / 256) * 12, 0, 0};
    EpiRowBf16 E{(bf16_t*)(p.ws + WS_HBUF), 3072, 3072};
    g8::gemm_phase(( __attribute__((address_space(3))) unsigned char*)lds, D_MODEL, D_MODEL, S, E);
}

__device__ __forceinline__ void ph_outproj1_g8(const Params& p, unsigned char* lds) {
    SchedDense S{(const char*)(p.ws + WS_Q + Q_O1), (const char*)(p.ws + WT_OUT_C), D_MODEL * 2, D_MODEL * 2, 4, (T / 256) * 4, 0, 0};
    EpiResidualBf16<false> E{(const void*)(p.ws + WS_XB), (bf16_t*)(p.ws + WS_HBUF + HB_YB)};
    g8::gemm_phase((__attribute__((address_space(3))) unsigned char*)lds, D_MODEL, D_MODEL, S, E);
}
__device__ __forceinline__ void ph_outproj0_g8(const Params& p, unsigned char* lds) {
    SchedDense S{(const char*)(p.ws + WS_HBUF + HB_AOC), (const char*)(p.ws + WT_OUT_AB), D_MODEL * 2, D_MODEL * 2, 4, (T / 256) * 4, 0, 0};
    EpiResidualBf16<false> E{(const void*)(p.ws + WS_XB), (bf16_t*)(p.ws + WS_HBUF + HB_YB)};
    g8::gemm_phase((__attribute__((address_space(3))) unsigned char*)lds, D_MODEL, D_MODEL, S, E);
}
__device__ __forceinline__ void ph_inproj0_g8(const Params& p, unsigned char* lds) {
    {
        SchedDense S{(const char*)(p.ws + WS_XB), (const char*)(p.ws + WT_IN_AB), D_MODEL * 2, D_MODEL * 2, 8, (T / 256) * 6, 4, 6};
        EpiRowBf16 E{(bf16_t*)(p.ws + WS_HBUF), H0_LD, AB_IN};
        g8::gemm_phase((__attribute__((address_space(3))) unsigned char*)lds, D_MODEL, D_MODEL, S, E);
    }
    {
        SchedDense S{(const char*)(p.ws + WT_IN_AB) + (size_t)1024 * D_MODEL * 2, (const char*)(p.ws + WS_XB), D_MODEL * 2, D_MODEL * 2, T / 256, 2 * (T / 256), 0, 0};
        EpiRowBf16 E{(bf16_t*)(p.ws + WS_Q + Q_VTA), VT_LD, T};
        g8::gemm_phase((__attribute__((address_space(3))) unsigned char*)lds, D_MODEL, D_MODEL, S, E);
    }
}

__device__ __forceinline__ float diff_lambda(const Params& p) {
    float d1 = 0.f, d2 = 0.f;
    for (int i = 0; i < 64; ++i) { d1 += p.in[2][i] * p.in[3][i]; d2 += p.in[4][i] * p.in[5][i]; }
    return expf(d1) - expf(d2) + 0.2f;
}
constexpr int LDS_X = 147456;

struct EpiMlaQ {
    bf16_t* qb; const float* rs;
    __device__ __forceinline__ void operator()(const g8::f32x4 (&acc)[2][2][4][2], const g8::Unit& u, int wr, int wc, int fr, int fq) const {
#pragma unroll
        for (int ai = 0; ai < 2; ++ai)
#pragma unroll
            for (int m = 0; m < 4; ++m) {
                const int tok = u.r0 + 128 * ai + 64 * wr + 16 * m + fr;
                const float r = rs[tok];
#pragma unroll
                for (int bj = 0; bj < 2; ++bj) {
                    const int cb = u.c0 + 128 * bj + 32 * wc;
                    if (cb >= 384) continue;
                    const int g32 = cb >> 5, head = g32 / 3, part = g32 % 3;
                    float v[8];
#pragma unroll
                    for (int e = 0; e < 4; ++e) { v[e] = acc[ai][bj][m][0][e] * r; v[4 + e] = acc[ai][bj][m][1][e] * r; }
                    u32x4 w; w.x = pk2(v[0], v[1]); w.y = pk2(v[2], v[3]); w.z = pk2(v[4], v[5]); w.w = pk2(v[6], v[7]);
                    *(u32x4*)(qb + ((size_t)tok * 4 + head) * 96 + part * 32 + 8 * fq) = w;
                }
            }
    }
};
struct EpiMlaK {
    bf16_t* kb; const float* rs;
    __device__ __forceinline__ void operator()(const g8::f32x4 (&acc)[2][2][4][2], const g8::Unit& u, int wr, int wc, int fr, int fq) const {
#pragma unroll
        for (int ai = 0; ai < 2; ++ai)
#pragma unroll
            for (int m = 0; m < 4; ++m) {
                const int tok = u.r0 + 128 * ai + 64 * wr + 16 * m + fr;
                const float r = rs[tok];
#pragma unroll
                for (int bj = 0; bj < 2; ++bj) {
                    const int c = 128 * bj + 32 * wc + 8 * fq;
                    const g8::f32x4 v0 = acc[ai][bj][m][0], v1 = acc[ai][bj][m][1];
                    u32x4 w; w.x = pk2(v0[0] * r, v0[1] * r); w.y = pk2(v0[2] * r, v0[3] * r); w.z = pk2(v1[0] * r, v1[1] * r); w.w = pk2(v1[2] * r, v1[3] * r);
                    *(u32x4*)(kb + ((size_t)tok * 4 + (c >> 6)) * 96 + (c & 63)) = w;
                }
            }
    }
};
struct EpiMlaVt {
    bf16_t* vt; const float* rs;
    __device__ __forceinline__ void operator()(const g8::f32x4 (&acc)[2][2][4][2], const g8::Unit& u, int wr, int wc, int fr, int fq) const {
#pragma unroll
        for (int bj = 0; bj < 2; ++bj) {
            const int tk = u.c0 + 128 * bj + 32 * wc + 8 * fq;
            const float4 ra = *(const float4*)(rs + tk), rb = *(const float4*)(rs + tk + 4);
#pragma unroll
            for (int ai = 0; ai < 2; ++ai)
#pragma unroll
                for (int m = 0; m < 4; ++m) {
                    const int row = u.r0 + 128 * ai + 64 * wr + 16 * m + fr;
                    const g8::f32x4 v0 = acc[ai][bj][m][0], v1 = acc[ai][bj][m][1];
                    u32x4 w; w.x = pk2(v0[0] * ra.x, v0[1] * ra.y); w.y = pk2(v0[2] * ra.z, v0[3] * ra.w); w.z = pk2(v1[0] * rb.x, v1[1] * rb.y); w.w = pk2(v1[2] * rb.z, v1[3] * rb.w);
                    *(u32x4*)(vt + (size_t)row * VT_LD + tk) = w;
                }
        }
    }
};
__device__ __forceinline__ void ph_mla_pre(const Params& p) {
    const bf16_t* h0 = (const bf16_t*)(p.ws + WS_HBUF);
    bf16_t* kb = (bf16_t*)(p.ws + WS_Q + Q_KB);
    float* rs = (float*)(p.ws + WS_RS);
    const int tid = thr(), lane = tid & 63, gw = (blockIdx.x * NTHREADS + tid) >> 6, ngw = (gridDim.x * NTHREADS) >> 6;
    for (int tb = gw * 4; tb < T; tb += ngw * 4) {
        u32x4 rv[4];
#pragma unroll
        for (int j = 0; j < 4; ++j) rv[j] = *(const u32x4*)(h0 + (size_t)(tb + j) * H0_LD + 1536 + (lane < 48 ? lane : 0) * 8);
#pragma unroll
        for (int j = 0; j < 4; ++j) {
            float ss = 0.f;
            { float f[8]; unpack8(rv[j], f);
#pragma unroll
              for (int e = 0; e < 8; ++e) ss += f[e] * f[e]; }
            float sq = lane < 32 ? ss : 0.f, skv = (lane >= 32 && lane < 48) ? ss : 0.f;
            sq = wave_sum(sq); skv = wave_sum(skv);
            if (lane == 0) { rs[tb + j] = rsqrtf(sq * (1.f / 256.f) + EPS); rs[T + tb + j] = rsqrtf(skv * (1.f / 128.f) + EPS); }
        }
    }
    for (int e = blockIdx.x * NTHREADS + tid; e < T * 2; e += gridDim.x * NTHREADS) {
        const int m = e >> 1, hf = e & 1, s = m % SEQ;
        float t1[8], t2[8], o1[8], o2[8];
        unpack8(*(const u32x4*)(h0 + (size_t)m * H0_LD + 1920 + 8 * hf), t1); unpack8(*(const u32x4*)(h0 + (size_t)m * H0_LD + 1936 + 8 * hf), t2);
#pragma unroll
        for (int j = 0; j < 8; ++j) { float c, sn; rope_cs(s, 8 * hf + j, c, sn); o1[j] = t1[j] * c - t2[j] * sn; o2[j] = t1[j] * sn + t2[j] * c; }
        u32x4 a, b;
        a.x = pk2(o1[0], o1[1]); a.y = pk2(o1[2], o1[3]); a.z = pk2(o1[4], o1[5]); a.w = pk2(o1[6], o1[7]);
        b.x = pk2(o2[0], o2[1]); b.y = pk2(o2[2], o2[3]); b.z = pk2(o2[4], o2[5]); b.w = pk2(o2[6], o2[7]);
#pragma unroll
        for (int h = 0; h < 4; ++h) { *(u32x4*)(kb + ((size_t)m * 4 + h) * 96 + 64 + 8 * hf) = a; *(u32x4*)(kb + ((size_t)m * 4 + h) * 96 + 80 + 8 * hf) = b; }
    }
}
__device__ __forceinline__ void ph_mla_up_g8(const Params& p, unsigned char* lds) {
    const char* h0 = (const char*)(p.ws + WS_HBUF);
    const float* rs = (const float*)(p.ws + WS_RS);
    {
        SchedDense S{h0 + 1536 * 2, (const char*)(p.ws + WT_UQ), H0_LD * 2, 256 * 2, 2, (T / 256) * 2, 0, 0};
        EpiMlaQ E{(bf16_t*)(p.ws + WS_Q + Q_QB), rs};
        g8::gemm_phase((__attribute__((address_space(3))) unsigned char*)lds, 256, 256, S, E);
    }
    {
        SchedDense S{h0 + 1792 * 2, (const char*)(p.ws + WT_UKV), H0_LD * 2, 128 * 2, 1, T / 256, 0, 0};
        EpiMlaK E{(bf16_t*)(p.ws + WS_Q + Q_KB), rs + T};
        g8::gemm_phase((__attribute__((address_space(3))) unsigned char*)lds, 128, 128, S, E);
    }
    {
        SchedDense S{(const char*)(p.ws + WT_UKV) + (size_t)256 * 128 * 2, h0 + 1792 * 2, 128 * 2, H0_LD * 2, T / 256, 2 * (T / 256), 0, 0};
        EpiMlaVt E{(bf16_t*)(p.ws + WS_Q + Q_VB), rs + T};
        g8::gemm_phase((__attribute__((address_space(3))) unsigned char*)lds, 128, H0_LD, S, E);
    }
}

constexpr size_t Q_WGU = 0, Q_WD = 64 * MiB;
struct CvtTile { const float* W; bf16_t* Wt; int N, K, k0, n0, kind; };
__device__ __forceinline__ bool cvt_moe_tile(const Params& p, int layer, int it, CvtTile& t) {
    if (it >= 3 * 32 * 32) return false;
    const int which = it >> 10, r = it & 1023, e = r >> 5, tile = r & 31;
    t.kind = which;
    if (which < 2) {
        t.W = p.in[20 + which] + ((size_t)layer * MOE_E + e) * D_MODEL * MOE_H; t.Wt = (bf16_t*)(p.ws + WS_Q + Q_WGU) + (size_t)e * 1024 * 1024;
        t.N = MOE_H; t.K = D_MODEL; t.k0 = (tile >> 1) * 64; t.n0 = (tile & 1) * 256;
    } else {
        t.W = p.in[22] + ((size_t)layer * MOE_E + e) * MOE_H * D_MODEL; t.Wt = (bf16_t*)(p.ws + WS_Q + Q_WD) + (size_t)e * 1024 * 512;
        t.N = D_MODEL; t.K = MOE_H; t.k0 = (tile >> 2) * 64; t.n0 = (tile & 3) * 256;
    }
    return true;
}
__device__ __forceinline__ void ph_cvt_moe(const Params& p, int layer, unsigned char* lds) {
    const int tid = thr(), lane = tid & 63, wave = tid >> 6;
    __syncthreads();
    const float* Wg = p.in[20] + (size_t)layer * MOE_E * D_MODEL * MOE_H; const float* Wu = p.in[21] + (size_t)layer * MOE_E * D_MODEL * MOE_H;
    const float* Wd = p.in[22] + (size_t)layer * MOE_E * MOE_H * D_MODEL;
    bf16_t* wgu = (bf16_t*)(p.ws + WS_Q + Q_WGU); bf16_t* wd = (bf16_t*)(p.ws + WS_Q + Q_WD);
    int i = 0;
    for (int it = blockIdx.x; it < 3 * 32 * 32; it += gridDim.x, ++i) {
        const int which = it >> 10, r = it & 1023, ex = r >> 5, tile = r & 31;
        CvtTile t;
        t.kind = which;
        if (which < 2) { t.W = (which ? Wu : Wg) + (size_t)ex * D_MODEL * MOE_H; t.Wt = wgu + (size_t)ex * 1024 * 1024; t.N = MOE_H; t.K = D_MODEL; t.k0 = (tile >> 1) * 64; t.n0 = (tile & 1) * 256; }
        else { t.W = Wd + (size_t)ex * MOE_H * D_MODEL; t.Wt = wd + (size_t)ex * 1024 * 512; t.N = D_MODEL; t.K = MOE_H; t.k0 = (tile >> 2) * 64; t.n0 = (tile & 3) * 256; }
        float4 va[8];
#pragma unroll
        for (int e = 0; e < 8; ++e) va[e] = *(const float4*)(t.W + (size_t)(t.k0 + 8 * wave + e) * t.N + t.n0 + 4 * lane);
        unsigned char* buf = lds + (i & 1) * 32768;
        {
            const float c0[8] = {va[0].x, va[1].x, va[2].x, va[3].x, va[4].x, va[5].x, va[6].x, va[7].x}, c1[8] = {va[0].y, va[1].y, va[2].y, va[3].y, va[4].y, va[5].y, va[6].y, va[7].y};
            const float c2[8] = {va[0].z, va[1].z, va[2].z, va[3].z, va[4].z, va[5].z, va[6].z, va[7].z}, c3[8] = {va[0].w, va[1].w, va[2].w, va[3].w, va[4].w, va[5].w, va[6].w, va[7].w};
            const int sw = (wave ^ (lane & 7)) << 4;
            u32x4 o;
            o.x = pk2(c0[0], c0[1]); o.y = pk2(c0[2], c0[3]); o.z = pk2(c0[4], c0[5]); o.w = pk2(c0[6], c0[7]); *(u32x4*)(buf + (4 * lane + 0) * 128 + sw) = o;
            o.x = pk2(c1[0], c1[1]); o.y = pk2(c1[2], c1[3]); o.z = pk2(c1[4], c1[5]); o.w = pk2(c1[6], c1[7]); *(u32x4*)(buf + (4 * lane + 1) * 128 + sw) = o;
            o.x = pk2(c2[0], c2[1]); o.y = pk2(c2[2], c2[3]); o.z = pk2(c2[4], c2[5]); o.w = pk2(c2[6], c2[7]); *(u32x4*)(buf + (4 * lane + 2) * 128 + sw) = o;
            o.x = pk2(c3[0], c3[1]); o.y = pk2(c3[2], c3[3]); o.z = pk2(c3[4], c3[5]); o.w = pk2(c3[6], c3[7]); *(u32x4*)(buf + (4 * lane + 3) * 128 + sw) = o;
        }
        __syncthreads();
#pragma unroll
        for (int q = 0; q < 4; ++q) {
            const int c = tid + NTHREADS * q, n = c >> 3, ch = c & 7;
            const u32x4 a = *(const u32x4*)(buf + n * 128 + ((ch ^ ((n >> 2) & 7)) << 4));
            const int hd = t.n0 + n;
            const int row = t.kind == 2 ? hd : 256 * (hd >> 7) + 128 * t.kind + (hd & 127);
            *(u32x4*)(t.Wt + (size_t)row * t.K + t.k0 + 8 * ch) = a;
        }
    }
    __syncthreads();
}

__device__ __forceinline__ void ph_moe_up_g8(const Params& p, int layer, unsigned char* lds) {
    int* sbase = (int*)(lds + LDS_X); int* stile = sbase + 40;
    moe_prefix(p, layer, sbase, stile);
    const int U = 4 * stile[32], G = gridDim.x, rem = U % G, umain = (2 * rem <= G) ? U - rem : U;
    SchedMoe<true> S{(const char*)(p.ws + WS_XB), (const char*)(p.ws + WS_Q + Q_WGU), D_MODEL * 2, (size_t)1024 * D_MODEL * 2, sbase, stile, (const int*)(p.ws + WS_LTOK), umain};
    EpiMoeUp E{(bf16_t*)(p.ws + WS_HBUF + HB_H)};
    g8::gemm_phase((__attribute__((address_space(3))) unsigned char*)lds, D_MODEL, D_MODEL, S, E);
    if (umain < U) g8::gemm_quarter_moe<true>((__attribute__((address_space(3))) unsigned char*)lds, D_MODEL, D_MODEL, S, umain, 4 * (U - umain), (bf16_t*)(p.ws + WS_HBUF + HB_H), nullptr);
}
__device__ __forceinline__ void ph_moe_down_g8(const Params& p, int layer, unsigned char* lds) {
    int* sbase = (int*)(lds + LDS_X); int* stile = sbase + 40;
    moe_prefix(p, layer, sbase, stile);
    const int U = 4 * stile[32], G = gridDim.x, rem = U % G, umain = (2 * rem <= G) ? U - rem : U;
    SchedMoe<false> S{(const char*)(p.ws + WS_HBUF + HB_H), (const char*)(p.ws + WS_Q + Q_WD), MOE_H * 2, (size_t)1024 * MOE_H * 2, sbase, stile, nullptr, umain};
    EpiMoeDown E{(bf16_t*)(p.ws + WS_HBUF + HB_Y), (const float*)(p.ws + WS_LW)};
    g8::gemm_phase((__attribute__((address_space(3))) unsigned char*)lds, MOE_H, MOE_H, S, E);
    if (umain < U) g8::gemm_quarter_moe<false>((__attribute__((address_space(3))) unsigned char*)lds, MOE_H, MOE_H, S, umain, 4 * (U - umain), (bf16_t*)(p.ws + WS_HBUF + HB_Y), (const float*)(p.ws + WS_LW));
}

template <int DQK> __device__ __forceinline__ int kswz(int row, int c) { return DQK == 64 ? row * 128 + ((c ^ ((row >> 1) & 7)) << 4) : row * 192 + ((c ^ ((row >> 2) & 3)) << 4); }
constexpr int ATT_STAGE = 28672, ATT_VOFF = 12288;
constexpr float ATT_THR = 14.0f;

constexpr int ATT_K0 = 0, ATT_K1 = 12288, ATT_V0 = 24576, ATT_V1 = 40960;
template <int DQK, bool BIAS>
__device__ __forceinline__ void attn0_item(const bf16_t* __restrict__ Qp, int ldq, const bf16_t* __restrict__ Kp, const bf16_t* __restrict__ VTp, int ldvt, bf16_t* Op, float scale_l2, float slope_l2, int q0, unsigned char* lds, bool combine, float lam) {
    constexpr int NS = DQK / 16, KCH = DQK / 8, NKL = (64 * KCH + NTHREADS - 1) / NTHREADS;
    const int tid = thr(), lane = tid & 63, wave = tid >> 6, fr = lane & 31, fh = lane >> 5;
    const int pr = (fr & ~12) | ((fr & 4) << 1) | ((fr & 8) >> 1);
    bf16x8 qf[NS];
    {
        const bf16_t* qrow = Qp + (size_t)(q0 + wave * 32 + fr) * ldq + 8 * fh;
#pragma unroll
        for (int s = 0; s < (DQK == 96 ? 4 : NS); ++s) {
            float f[8]; unpack8(*(const u32x4*)(qrow + 16 * s), f);
            u32x4 o; o.x = pk2(f[0] * scale_l2, f[1] * scale_l2); o.y = pk2(f[2] * scale_l2, f[3] * scale_l2); o.z = pk2(f[4] * scale_l2, f[5] * scale_l2); o.w = pk2(f[6] * scale_l2, f[7] * scale_l2);
            qf[s] = __builtin_bit_cast(bf16x8, o);
        }
        if (DQK == 96) {
            float f1[8], f2[8], o1[8], o2[8];
            unpack8(*(const u32x4*)(qrow + 64), f1); unpack8(*(const u32x4*)(qrow + 80), f2);
            const int spos = q0 + wave * 32 + fr;
#pragma unroll
            for (int j = 0; j < 8; ++j) {
                float c, sn; rope_cs(spos, 8 * fh + j, c, sn);
                o1[j] = (f1[j] * c - f2[j] * sn) * scale_l2; o2[j] = (f1[j] * sn + f2[j] * c) * scale_l2;
            }
            u32x4 a, b;
            a.x = pk2(o1[0], o1[1]); a.y = pk2(o1[2], o1[3]); a.z = pk2(o1[4], o1[5]); a.w = pk2(o1[6], o1[7]);
            b.x = pk2(o2[0], o2[1]); b.y = pk2(o2[2], o2[3]); b.z = pk2(o2[4], o2[5]); b.w = pk2(o2[6], o2[7]);
            qf[NS - 2] = __builtin_bit_cast(bf16x8, a); qf[NS - 1] = __builtin_bit_cast(bf16x8, b);
        }
    }
    f32x16 O[4];
#pragma unroll
    for (int d = 0; d < 4; ++d)
#pragma unroll
        for (int r = 0; r < 16; ++r) O[d][r] = 0.f;
    float m = -1e30f, l = 0.f;
    const float qposf = (float)(q0 + wave * 32 + fr);
    u32x4 kr[NKL], vr[2];
    auto gloadK = [&](int k0) {
#pragma unroll
        for (int i = 0; i < NKL; ++i) { const int idx = tid + NTHREADS * i, row = idx / KCH, c = idx % KCH; if (idx < 64 * KCH) kr[i] = *(const u32x4*)(Kp + (size_t)(k0 + row) * ldq + c * 8); }
    };
    auto gloadV = [&](int k0) {
#pragma unroll
        for (int i = 0; i < 2; ++i) { const int row = (tid >> 3) + 64 * i, c = tid & 7; vr[i] = *(const u32x4*)(VTp + (size_t)row * ldvt + k0 + c * 8); }
    };
    auto lstoreK = [&](unsigned char* st) {
#pragma unroll
        for (int i = 0; i < NKL; ++i) { const int idx = tid + NTHREADS * i, row = idx / KCH, c = idx % KCH; if (idx < 64 * KCH) *(u32x4*)(st + kswz<DQK>(row, c)) = kr[i]; }
    };
    auto lstoreV = [&](unsigned char* st) {
#pragma unroll
        for (int i = 0; i < 2; ++i) { const int row = (tid >> 3) + 64 * i, c = tid & 7; *(u32x4*)(st + swz128(row, c)) = vr[i]; }
    };
    auto qk = [&](const unsigned char* kt, f32x16& S0, f32x16& S1) {
#pragma unroll
        for (int r = 0; r < 16; ++r) { S0[r] = 0.f; S1[r] = 0.f; }
        constexpr int NM = 2 * NS;
        bf16x8 kf[4];
#pragma unroll
        for (int i = 0; i < 3; ++i) kf[i] = *(const bf16x8*)(kt + kswz<DQK>((i & 1) * 32 + pr, 2 * (i >> 1) + fh));
        __builtin_amdgcn_sched_barrier(0);
#pragma unroll
        for (int i = 0; i < NM; ++i) {
            if (i + 3 < NM) kf[(i + 3) & 3] = *(const bf16x8*)(kt + kswz<DQK>(((i + 3) & 1) * 32 + pr, 2 * ((i + 3) >> 1) + fh));
            if (i & 1) S1 = MFMA32(kf[i & 3], qf[i >> 1], S1); else S0 = MFMA32(kf[i & 3], qf[i >> 1], S0);
            __builtin_amdgcn_sched_barrier(0);
        }
    };
    constexpr int NT = SEQ / 64;
    gloadK(0); gloadV(0);
    __syncthreads();
    lstoreK(lds + ATT_K0); lstoreV(lds + ATT_V0);
    gloadK(64);
    lstoreK(lds + ATT_K1);
    __syncthreads();
    f32x16 SA0, SA1, SB0, SB1;
    qk(lds + ATT_K0, SA0, SA1);
    __syncthreads();
    const bool late = __builtin_amdgcn_readfirstlane(wave) >= 4;
    if (late) __builtin_amdgcn_s_setprio(1);
    auto tile = [&](int t, f32x16& Sc0, f32x16& Sc1, f32x16& Sn0, f32x16& Sn1) {
        const bool more1 = t + 1 < NT, more2 = t + 2 < NT;
        if (more2) gloadK((t + 2) * 64);
        if (more1) gloadV((t + 1) * 64);
        if (more1 && !late) qk(lds + (((t + 1) & 1) ? ATT_K1 : ATT_K0), Sn0, Sn1);
        float mx = -1e30f, mxb = -1e30f;
        if (BIAS) {
            const float dq = (float)(t * 64 + 8 * fh) - qposf;
#pragma unroll
            for (int r = 0; r < 16; ++r) {
                const float c0 = (float)(16 * (r >> 3) + (r & 7));
                Sc0[r] = fmaf(fabsf(dq + c0), -slope_l2, Sc0[r]);
                Sc1[r] = fmaf(fabsf(dq + c0 + 32.f), -slope_l2, Sc1[r]);
                if (r & 1) mxb = max3_s(mxb, Sc0[r], Sc1[r]); else mx = max3_s(mx, Sc0[r], Sc1[r]);
            }
        } else {
#pragma unroll
            for (int r = 0; r < 16; ++r) { if (r & 1) mxb = max3_s(mxb, Sc0[r], Sc1[r]); else mx = max3_s(mx, Sc0[r], Sc1[r]); }
        }
        mx = max3_s(mx, mxb, -1e30f);
        mx = xor32_max(mx);
        if (__any(mx > m + ATT_THR)) {
            const float mn = fmaxf(m, mx), alpha = __builtin_amdgcn_exp2f(m - mn);
            m = mn; l *= alpha;
#pragma unroll
            for (int d = 0; d < 4; ++d)
#pragma unroll
                for (int r = 0; r < 16; ++r) O[d][r] *= alpha;
        }
        float ls = 0.f;
#pragma unroll
        for (int r = 0; r < 16; ++r) { Sc0[r] = __builtin_amdgcn_exp2f(Sc0[r] - m); Sc1[r] = __builtin_amdgcn_exp2f(Sc1[r] - m); ls += Sc0[r] + Sc1[r]; }
        l += ls;
        bf16x8 pf[2][2];
#pragma unroll
        for (int s2 = 0; s2 < 2; ++s2) {
            u32x4 a, b;
            a.x = pk2(Sc0[8 * s2 + 0], Sc0[8 * s2 + 1]); a.y = pk2(Sc0[8 * s2 + 2], Sc0[8 * s2 + 3]); a.z = pk2(Sc0[8 * s2 + 4], Sc0[8 * s2 + 5]); a.w = pk2(Sc0[8 * s2 + 6], Sc0[8 * s2 + 7]);
            b.x = pk2(Sc1[8 * s2 + 0], Sc1[8 * s2 + 1]); b.y = pk2(Sc1[8 * s2 + 2], Sc1[8 * s2 + 3]); b.z = pk2(Sc1[8 * s2 + 4], Sc1[8 * s2 + 5]); b.w = pk2(Sc1[8 * s2 + 6], Sc1[8 * s2 + 7]);
            pf[0][s2] = __builtin_bit_cast(bf16x8, a); pf[1][s2] = __builtin_bit_cast(bf16x8, b);
        }
        const unsigned char* vt = lds + ((t & 1) ? ATT_V1 : ATT_V0);
        {
            bf16x8 vfr[4];
#pragma unroll
            for (int i = 0; i < 3; ++i) vfr[i] = *(const bf16x8*)(vt + swz128(32 * (i & 3) + fr, 4 * (i >> 3) + 2 * ((i >> 2) & 1) + fh));
            __builtin_amdgcn_sched_barrier(0);
#pragma unroll
            for (int i = 0; i < 16; ++i) {
                if (i + 3 < 16) vfr[(i + 3) & 3] = *(const bf16x8*)(vt + swz128(32 * ((i + 3) & 3) + fr, 4 * ((i + 3) >> 3) + 2 * (((i + 3) >> 2) & 1) + fh));
                O[i & 3] = MFMA32(vfr[i & 3], pf[i >> 3][(i >> 2) & 1], O[i & 3]);
                __builtin_amdgcn_sched_barrier(0);
            }
        }
        if (more1 && late) qk(lds + (((t + 1) & 1) ? ATT_K1 : ATT_K0), Sn0, Sn1);
        if (more2) lstoreK(lds + ((t & 1) ? ATT_K1 : ATT_K0));
        if (more1) lstoreV(lds + ((t & 1) ? ATT_V0 : ATT_V1));
        __syncthreads();
    };
#pragma unroll 1
    for (int t = 0; t < NT; t += 2) {
        tile(t, SA0, SA1, SB0, SB1);
        tile(t + 1, SB0, SB1, SA0, SA1);
    }
    __builtin_amdgcn_s_setprio(0);
    l += __shfl_xor(l, 32);
    const float inv = 1.f / l;
    bf16_t* orow = Op + (size_t)(q0 + wave * 32 + fr) * D_MODEL + 4 * fh;
    if (combine) {
        float ss = 0.f;
#pragma unroll
        for (int d = 0; d < 4; ++d)
#pragma unroll
            for (int q = 0; q < 4; ++q) {
                const uint2 o1 = *(const uint2*)(orow + 32 * d + 8 * q);
                const float d0 = __uint_as_float(o1.x << 16) - lam * (O[d][4 * q] * inv), d1 = __uint_as_float(o1.x & 0xffff0000u) - lam * (O[d][4 * q + 1] * inv);
                const float d2 = __uint_as_float(o1.y << 16) - lam * (O[d][4 * q + 2] * inv), d3 = __uint_as_float(o1.y & 0xffff0000u) - lam * (O[d][4 * q + 3] * inv);
                O[d][4 * q] = d0; O[d][4 * q + 1] = d1; O[d][4 * q + 2] = d2; O[d][4 * q + 3] = d3;
                ss += (d0 * d0 + d1 * d1) + (d2 * d2 + d3 * d3);
            }
        ss += __shfl_xor(ss, 32);
        const float r = rsqrtf(ss * (1.f / 128.f) + EPS);
#pragma unroll
        for (int d = 0; d < 4; ++d)
#pragma unroll
            for (int q = 0; q < 4; ++q) { uint2 o; o.x = pk2(O[d][4 * q] * r, O[d][4 * q + 1] * r); o.y = pk2(O[d][4 * q + 2] * r, O[d][4 * q + 3] * r); *(uint2*)(orow + 32 * d + 8 * q) = o; }
    } else {
#pragma unroll
        for (int d = 0; d < 4; ++d)
#pragma unroll
            for (int q = 0; q < 4; ++q) { uint2 o; o.x = pk2(O[d][4 * q] * inv, O[d][4 * q + 1] * inv); o.y = pk2(O[d][4 * q + 2] * inv, O[d][4 * q + 3] * inv); *(uint2*)(orow + 32 * d + 8 * q) = o; }
    }
}

__device__ __forceinline__ void ph_attn0_f(const Params& p, unsigned char* lds) {
    const bf16_t* h0 = (const bf16_t*)(p.ws + WS_HBUF);
    const bf16_t* qb = (const bf16_t*)(p.ws + WS_Q + Q_QB);
    const bf16_t* kb = (const bf16_t*)(p.ws + WS_Q + Q_KB);
    const bf16_t* vtB = (const bf16_t*)(p.ws + WS_Q + Q_VB);
    const bf16_t* vtA = (const bf16_t*)(p.ws + WS_Q + Q_VTA);
    bf16_t* aoc = (bf16_t*)(p.ws + WS_HBUF + HB_AOC);
    const float lam = diff_lambda(p);
    const int G = gridDim.x, bid = blockIdx.x;
    const bool xmap = (G % 128) == 0;
    const int cpr = xmap ? (G / 8) / 16 : 0;
    for (int k = 0;; ++k) {
        int pairidx, qblk;
        if (xmap) { const int xcd = bid & 7, j = bid >> 3; pairidx = (k * 8 + xcd) * cpr + (j >> 4); qblk = j & 15; }
        else { const int it = bid + k * G; pairidx = it >> 4; qblk = it & 15; }
        if (pairidx >= 48) break;
        const int b = pairidx / 6, pp = pairidx % 6;
#pragma unroll 1
        for (int half = 0; half < 2; ++half) {
            if (pp < 4) {
                const int h = pp ^ (pp >> 1), map = half;
                const bf16_t* Qp = h0 + (size_t)b * SEQ * H0_LD + h * 128 + map * 64;
                attn0_item<64, true>(Qp, H0_LD, Qp + 512, vtA + (size_t)(h * 128) * VT_LD + (size_t)b * SEQ, VT_LD, aoc + (size_t)b * SEQ * D_MODEL + h * 128,
                                     0.125f * 1.4426950408889634f, exp2f(-2.0f * (float)(h + 1)) * 1.4426950408889634f, qblk * 256, lds, map == 1, lam);
            } else {
                const int h = 2 * (pp - 4) + half;
                attn0_item<96, false>(qb + ((size_t)b * SEQ * 4 + h) * 96, 384, kb + ((size_t)b * SEQ * 4 + h) * 96, vtB + (size_t)(h * 128) * VT_LD + (size_t)b * SEQ, VT_LD,
                                      aoc + (size_t)b * SEQ * D_MODEL + 512 + h * 128, 0.10206207261596575f * 1.4426950408889634f, 0.f, qblk * 256, lds, false, 0.f);
            }
        }
    }
}

constexpr int DIL_VOFF = 49152, DIL_SCR = 98304;
__device__ __forceinline__ int vswz(int row, int c) { return row * 128 + ((c ^ (((row >> 1) & 1) << 2)) << 4); }

struct DilRegs { u32x4 kr[6], vr[6]; bf16x8 qf[4]; };
__device__ __forceinline__ void dil_load(const Params& p, int pat, int b, int h, int j, DilRegs& R) {
    const bf16_t* h1 = (const bf16_t*)(p.ws + WS_HBUF);
    const int l2d = 2 * pat, SD = SEQ >> l2d, nqb = SD >> 8, res = j / nqb, qblk = j % nqb, m0 = qblk * 256;
    const int tid = thr(), lane = tid & 63, wave = tid >> 6, fr = lane & 31, fh = lane >> 5, c = tid & 7;
    const size_t tokbase = (size_t)b * SEQ + res;
#pragma unroll
    for (int i = 0; i < 6; ++i) {
        const int rowl = (tid >> 3) + 64 * i;
        int m = m0 - 64 + rowl; m = m < 0 ? 0 : (m >= SD ? SD - 1 : m);
        const bf16_t* src = h1 + (tokbase + ((size_t)m << l2d)) * 3072 + 1024 + h * 64 + c * 8;
        R.kr[i] = *(const u32x4*)src; R.vr[i] = *(const u32x4*)(src + 1024);
    }
    const bf16_t* qrow = h1 + (tokbase + ((size_t)(m0 + wave * 32 + fr) << l2d)) * 3072 + h * 64 + 8 * fh;
#pragma unroll
    for (int s = 0; s < 4; ++s) R.qf[s] = *(const bf16x8*)(qrow + 16 * s);
}

template <bool FINAL>
__device__ __forceinline__ void dil_item(const Params& p, int pat, int b, int h, int j, DilRegs& R, bool has_next, int npat, int nb, int nh, int nj, unsigned char* lds) {
    const int l2d = 2 * pat, d = 1 << l2d, SD = SEQ >> l2d;
    const int nqb = SD >> 8, res = j / nqb, qblk = j % nqb, m0 = qblk * 256;
    const int tid = thr(), lane = tid & 63, wave = tid >> 6, fr = lane & 31, fh = lane >> 5;
    const int pr = (fr & ~12) | ((fr & 4) << 1) | ((fr & 8) >> 1);
    const size_t tokbase = (size_t)b * SEQ + res;
    __syncthreads();
    {
        const int c = tid & 7;
#pragma unroll
        for (int i = 0; i < 6; ++i) {
            const int rowl = (tid >> 3) + 64 * i;
            *(u32x4*)(lds + swz128(rowl, c)) = R.kr[i]; *(u32x4*)(lds + DIL_VOFF + vswz(rowl, c)) = R.vr[i];
        }
    }
    bf16x8 qf[4];
#pragma unroll
    for (int s = 0; s < 4; ++s) qf[s] = R.qf[s];
    const int mq = m0 + wave * 32 + fr;
    const size_t qtok = tokbase + ((size_t)mq << l2d);
    __syncthreads();
    if (has_next) dil_load(p, npat, nb, nh, nj, R);
    u32x4 pf1[4], pf2[4]; float pl1 = 0.f, pl2 = 0.f;
    if (FINAL) {
        const bf16_t* opart_c = (const bf16_t*)(p.ws + WS_Q + Q_OPART); const float* lsb_c = (const float*)(p.ws + WS_Q + Q_LSE);
        pl1 = lsb_c[qtok * 16 + h]; pl2 = lsb_c[((size_t)T + qtok) * 16 + h];
#pragma unroll
        for (int it = 0; it < 4; ++it) {
            const size_t rtok = tokbase + ((size_t)(m0 + wave * 32 + it * 8 + (lane >> 3)) << l2d);
            pf1[it] = *(const u32x4*)(opart_c + rtok * D_MODEL + h * 64 + (lane & 7) * 8);
            pf2[it] = *(const u32x4*)(opart_c + ((size_t)T + rtok) * D_MODEL + h * 64 + (lane & 7) * 8);
        }
    }
    const float scale_l2 = 0.125f * 1.4426950408889634f;
    const float sl = exp2f(-0.5f * (float)(h + 1)) * 1.4426950408889634f * (float)d;
    const float dmb = (float)(8 * fh - 64 - fr);
    const int mkb = m0 + wave * 32 - 64 + 8 * fh;
    const int wlo = __builtin_amdgcn_readfirstlane(m0 + wave * 32 - 64);
    const bool edge = wlo < 0 || wlo + 160 > SD;
    float mx = -1e30f, l = 0.f;
    f32x16 O[2];
#pragma unroll
    for (int dv = 0; dv < 2; ++dv)
#pragma unroll
        for (int r = 0; r < 16; ++r) O[dv][r] = 0.f;
    const int tq = (lane & 15) >> 2, pp = lane & 3, blk = (lane >> 4) & 1, qq = (tq >> 1) & 1;
    const unsigned vb0 = (unsigned)(size_t)(lds + DIL_VOFF) + (unsigned)((32 * wave + 8 * fh + tq) * 128 + ((4 * (0 ^ qq) + 2 * blk + (pp >> 1)) << 4) + 8 * (pp & 1));
    const unsigned vb1 = (unsigned)(size_t)(lds + DIL_VOFF) + (unsigned)((32 * wave + 8 * fh + tq) * 128 + ((4 * (1 ^ qq) + 2 * blk + (pp >> 1)) << 4) + 8 * (pp & 1));
#ifndef DPROBE
#define DPROBE 0
#endif
#pragma unroll
    for (int u = 0; u < ((DPROBE & 1) ? 0 : 5); ++u) {
        f32x16 S;
#pragma unroll
        for (int r = 0; r < 16; ++r) S[r] = 0.f;
#pragma unroll
        for (int s = 0; s < 4; ++s) {
            const bf16x8 kf = *(const bf16x8*)(lds + swz128(32 * (wave + u) + pr, 2 * s + fh));
            S = MFMA32(kf, qf[s], S);
        }
        float tm = -1e30f;
        float dmu = dmb + (float)(32 * u); int mku = mkb + 32 * u;
        asm volatile("" : "+v"(dmu), "+v"(mku));
        if (!FINAL && u >= 1 && u <= 3 && !edge) {
#pragma unroll
            for (int r = 0; r < 16; ++r) {
                const int cst = 16 * (r >> 3) + (r & 7);
                const float t = fmaf(fabsf(dmu + (float)cst), -sl, S[r] * scale_l2);
                S[r] = t; tm = fmaxf(tm, t);
            }
        } else {
#pragma unroll
            for (int r = 0; r < 16; ++r) {
                const int cst = 16 * (r >> 3) + (r & 7);
                const float ad = fabsf(dmu + (float)cst);
                const bool ok = (ad <= 64.f) && ((unsigned)(mku + cst) < (unsigned)SD);
                const float t = ok ? fmaf(ad, -sl, S[r] * scale_l2) : -1e30f;
                S[r] = t; tm = fmaxf(tm, t);
            }
        }
        tm = xor32_max(tm);
        const float mn = fmaxf(mx, tm), alpha = __builtin_amdgcn_exp2f(mx - mn);
        mx = mn;
        float ls = 0.f;
#pragma unroll
        for (int r = 0; r < 16; ++r) { const float pv = __builtin_amdgcn_exp2f(S[r] - mn); S[r] = pv; ls += pv; }
        l = l * alpha + ls;
#pragma unroll
        for (int dv = 0; dv < 2; ++dv)
#pragma unroll
            for (int r = 0; r < 16; ++r) O[dv][r] *= alpha;
        typedef short s16x4 __attribute__((ext_vector_type(4)));
        s16x4 a0, a1, a2, a3, b0, b1, b2, b3;
        asm volatile(
            "ds_read_b64_tr_b16 %0, %8 offset:%10\n\t"
            "ds_read_b64_tr_b16 %1, %8 offset:%11\n\t"
            "ds_read_b64_tr_b16 %2, %8 offset:%12\n\t"
            "ds_read_b64_tr_b16 %3, %8 offset:%13\n\t"
            "ds_read_b64_tr_b16 %4, %9 offset:%10\n\t"
            "ds_read_b64_tr_b16 %5, %9 offset:%11\n\t"
            "ds_read_b64_tr_b16 %6, %9 offset:%12\n\t"
            "ds_read_b64_tr_b16 %7, %9 offset:%13\n\t"
            "s_waitcnt lgkmcnt(0)"
            : "=&v"(a0), "=&v"(a1), "=&v"(a2), "=&v"(a3), "=&v"(b0), "=&v"(b1), "=&v"(b2), "=&v"(b3)
            : "v"(vb0), "v"(vb1), "i"((32 * u + 0) * 128), "i"((32 * u + 4) * 128), "i"((32 * u + 16) * 128), "i"((32 * u + 20) * 128)
            : "memory");
        bf16x8 pf0, pf1;
        {
            u32x4 a, c2;
            a.x = pk2(S[0], S[1]); a.y = pk2(S[2], S[3]); a.z = pk2(S[4], S[5]); a.w = pk2(S[6], S[7]);
            c2.x = pk2(S[8], S[9]); c2.y = pk2(S[10], S[11]); c2.z = pk2(S[12], S[13]); c2.w = pk2(S[14], S[15]);
            pf0 = __builtin_bit_cast(bf16x8, a); pf1 = __builtin_bit_cast(bf16x8, c2);
        }
        const bf16x8 v00 = __builtin_shufflevector(a0, a1, 0, 1, 2, 3, 4, 5, 6, 7), v01 = __builtin_shufflevector(a2, a3, 0, 1, 2, 3, 4, 5, 6, 7);
        const bf16x8 v10 = __builtin_shufflevector(b0, b1, 0, 1, 2, 3, 4, 5, 6, 7), v11 = __builtin_shufflevector(b2, b3, 0, 1, 2, 3, 4, 5, 6, 7);
        O[0] = MFMA32(v00, pf0, O[0]); O[0] = MFMA32(v01, pf1, O[0]);
        O[1] = MFMA32(v10, pf0, O[1]); O[1] = MFMA32(v11, pf1, O[1]);
    }
    l += __shfl_xor(l, 32);
    const float inv = 1.f / l;
    const float lse = mx + __builtin_amdgcn_logf(l);
    bf16_t* opart = (bf16_t*)(p.ws + WS_Q + Q_OPART);
    float* lsb = (float*)(p.ws + WS_Q + Q_LSE);
    unsigned char* wscr = lds + DIL_SCR + wave * 4864;
    float* wgt = (float*)(wscr + 4608);
    float c0 = inv;
    if (FINAL) {
        const float l1 = pl1, l2 = pl2;
        const float M = fmaxf(lse, fmaxf(l1, l2));
        const float w0 = __builtin_amdgcn_exp2f(lse - M), w1 = __builtin_amdgcn_exp2f(l1 - M), w2 = __builtin_amdgcn_exp2f(l2 - M);
        const float wi = 1.f / (w0 + w1 + w2);
        c0 = w0 * wi * inv;
        if (fh == 0) { wgt[2 * fr] = w1 * wi; wgt[2 * fr + 1] = w2 * wi; }
    } else {
        if (fh == 0) lsb[((size_t)(pat - 1) * T + qtok) * 16 + h] = lse;
    }
#pragma unroll
    for (int dv = 0; dv < 2; ++dv)
#pragma unroll
        for (int q4 = 0; q4 < 4; ++q4) {
            uint2 o; o.x = pk2(O[dv][4 * q4] * c0, O[dv][4 * q4 + 1] * c0); o.y = pk2(O[dv][4 * q4 + 2] * c0, O[dv][4 * q4 + 3] * c0);
            *(uint2*)(wscr + fr * 144 + (32 * dv + 8 * q4 + 4 * fh) * 2) = o;
        }
    asm volatile("s_waitcnt lgkmcnt(0)" ::: "memory");
#pragma unroll
    for (int it = 0; it < 4; ++it) {
        const int r = it * 8 + (lane >> 3), ch = lane & 7;
        const size_t rtok = tokbase + ((size_t)(m0 + wave * 32 + r) << l2d);
        const u32x4 v = *(const u32x4*)(wscr + r * 144 + ch * 16);
        if (!FINAL) {
            *(u32x4*)(opart + ((size_t)(pat - 1) * T + rtok) * D_MODEL + h * 64 + ch * 8) = v;
        } else {
            const float c1 = wgt[2 * r], c2 = wgt[2 * r + 1];
            float f0[8], f1[8], f2[8];
            unpack8(v, f0);
            unpack8(pf1[it], f1);
            unpack8(pf2[it], f2);
            u32x4 o;
            o.x = pk2(f0[0] + c1 * f1[0] + c2 * f2[0], f0[1] + c1 * f1[1] + c2 * f2[1]); o.y = pk2(f0[2] + c1 * f1[2] + c2 * f2[2], f0[3] + c1 * f1[3] + c2 * f2[3]);
            o.z = pk2(f0[4] + c1 * f1[4] + c2 * f2[4], f0[5] + c1 * f1[5] + c2 * f2[5]); o.w = pk2(f0[6] + c1 * f1[6] + c2 * f2[6], f0[7] + c1 * f1[7] + c2 * f2[7]);
            *(u32x4*)((bf16_t*)(p.ws + WS_Q + Q_O1) + rtok * D_MODEL + h * 64 + ch * 8) = o;
        }
    }
}

template <bool FINAL>
__device__ __forceinline__ void ph_dil_f(const Params& p, unsigned char* lds) {
    const int G = gridDim.x, bid = blockIdx.x;
    const int ngroups = FINAL ? 128 : 256;
    const bool xmap = (G % 128) == 0;
    const int cpr = xmap ? (G / 8) / 16 : 0;
    auto decode = [&](int k, int& pat, int& bb, int& hh, int& j) -> bool {
        int grp;
        if (xmap) { const int xcd = bid & 7, jj = bid >> 3; grp = (k * 8 + xcd) * cpr + (jj >> 4); j = jj & 15; }
        else { const int it = bid + k * G; grp = it >> 4; j = it & 15; }
        if (grp >= ngroups) return false;
        const int bh = grp & 127; pat = FINAL ? 0 : 1 + (grp >> 7); bb = bh >> 4; hh = bh & 15;
        return true;
    };
    DilRegs R;
    int pat, bb, hh, j;
    if (!decode(0, pat, bb, hh, j)) return;
    dil_load(p, pat, bb, hh, j, R);
    for (int k = 0;; ++k) {
        int np = 0, nb = 0, nh = 0, nj = 0;
        const bool has_next = decode(k + 1, np, nb, nh, nj);
        dil_item<FINAL>(p, pat, bb, hh, j, R, has_next, np, nb, nh, nj, lds);
        if (!has_next) break;
        pat = np; bb = nb; hh = nh; j = nj;
    }
}

#define LAS __attribute__((address_space(3)))
#define XB_TMO      128
#define XB_XCNT(j)  (256  + 64 * (j))
#define XB_XSUB(j)  (1280 + 64 * (j))
#define XB_XGEN(j)  (2304 + 64 * (j))
#define XB_TOP      3328
#define XB_TOPGEN   3392
#define XB_SPIN_CAP (1u << 22)
constexpr int CW_BAR = 4096;
__device__ __forceinline__ unsigned xb_ld(unsigned* p)              { return __hip_atomic_load(p, __ATOMIC_RELAXED, __HIP_MEMORY_SCOPE_AGENT); }
__device__ __forceinline__ unsigned xb_add(unsigned* p, unsigned v) { return __hip_atomic_fetch_add(p, v, __ATOMIC_RELAXED, __HIP_MEMORY_SCOPE_AGENT); }
__device__ __forceinline__ unsigned xb_xcc_id() { return (unsigned)__builtin_amdgcn_s_getreg((3 << 11) | 20) & 0xFu; }
#define XB_SPIN(cond, bar) do { unsigned _sp = 0; while (cond) { __builtin_amdgcn_s_sleep(1); \
    if ((++_sp & 255u) == 0u) { if (xb_ld(&(bar)[XB_TMO])) break; if (_sp > XB_SPIN_CAP) { atomicAdd(&(bar)[XB_TMO], 1u); break; } } } } while (0)
struct XcdBarrier { unsigned* bar; unsigned x; volatile LAS unsigned* st; };
__device__ __forceinline__ XcdBarrier xcd_barrier_post(unsigned* bar, volatile LAS unsigned* st) {
    XcdBarrier b; b.bar = bar; b.x = xb_xcc_id(); b.st = st;
    if (threadIdx.x == 0) (void)xb_add(&bar[XB_XCNT(b.x)], 1u);
    return b;
}
__device__ __forceinline__ void xcd_barrier_complete(unsigned* bar, unsigned x, unsigned& nloc, unsigned& nx) {
    const unsigned G = gridDim.x * gridDim.y * gridDim.z;
    unsigned sum, cnt, mine, sp = 0u;
    for (;;) {
        sum = 0u; cnt = 0u; mine = 0u;
#pragma unroll
        for (unsigned j = 0; j < 16; ++j) { const unsigned c = xb_ld(&bar[XB_XCNT(j)]); sum += c; cnt += (c > 0u) ? 1u : 0u; mine = (j == x) ? c : mine; }
        if (sum == G) break;
        __builtin_amdgcn_s_sleep(1);
        if ((++sp & 255u) == 0u) { if (xb_ld(&bar[XB_TMO])) break; if (sp > XB_SPIN_CAP) { atomicAdd(&bar[XB_TMO], 1u); break; } }
    }
    nloc = mine > 0u ? mine : 1u; nx = cnt > 0u ? cnt : 1u;
}
__device__ __forceinline__ void xcd_barrier(const XcdBarrier& b) {
    asm volatile("s_waitcnt vmcnt(0)" ::: "memory");
    __syncthreads();
    if (threadIdx.x == 0) {
        unsigned* bar = b.bar;
        __builtin_amdgcn_s_waitcnt(0);
        unsigned nloc = b.st[0], nx = b.st[1];
        if (nloc == 0u) { xcd_barrier_complete(bar, b.x, nloc, nx); b.st[0] = nloc; b.st[1] = nx; }
        const unsigned old = xb_add(&bar[XB_XSUB(b.x)], 1u);
        const unsigned gen = old / nloc;
        if (old + 1u == (gen + 1u) * nloc) {
            __builtin_amdgcn_fence(__ATOMIC_RELEASE, "agent");
            asm volatile("s_waitcnt vmcnt(0)" ::: "memory");
            asm volatile("buffer_inv sc1" ::: "memory");
            const unsigned og = xb_add(&bar[XB_TOP], 1u);
            const unsigned tg = og / nx;
            if (og + 1u == (tg + 1u) * nx) xb_add(&bar[XB_TOPGEN], 1u);
            else XB_SPIN(xb_ld(&bar[XB_TOPGEN]) == tg, bar);
            asm volatile("s_waitcnt vmcnt(0)" ::: "memory");
            xb_add(&bar[XB_XGEN(b.x)], 1u);
            asm volatile("s_waitcnt vmcnt(0)" ::: "memory");
        } else {
            asm volatile("buffer_inv sc1" ::: "memory");
            XB_SPIN(xb_ld(&bar[XB_XGEN(b.x)]) == gen, bar);
            asm volatile("s_waitcnt vmcnt(0)" ::: "memory");
        }
    }
    __syncthreads();
}

__device__ __forceinline__ void ph_router_tables(const Params& p) {
    const int tid = thr();
    for (int layer = 0; layer < 2; ++layer) {
        const float* g = p.in[14] + layer * D_MODEL; const float* bta = p.in[15] + layer * D_MODEL;
        const float* wg = p.in[16] + (size_t)layer * D_MODEL * 4; const float* bg = p.in[17] + layer * 4;
        const float* wr = p.in[18] + (size_t)layer * D_MODEL * 32; const float* br = p.in[19] + layer * 32;
        float* tab = (float*)(p.ws + WS_RTAB) + (size_t)layer * D_MODEL * 36;
        float* cst = (float*)(p.ws + WS_RCONST) + layer * 72;
        for (int e = blockIdx.x * NTHREADS + tid; e < D_MODEL * 36; e += gridDim.x * NTHREADS) {
            const int k = e / 36, c = e % 36;
            tab[e] = g[k] * (c < 4 ? wg[k * 4 + c] : wr[k * 32 + (c - 4)]);
        }
        const int gw = (blockIdx.x * NTHREADS + tid) >> 6, lane = tid & 63;
        if (gw >= layer * 36 && gw < layer * 36 + 36) {
            const int c = gw - layer * 36; float s1 = 0.f, s0 = 0.f;
            for (int k = lane; k < D_MODEL; k += 64) { const float w = c < 4 ? wg[k * 4 + c] : wr[k * 32 + (c - 4)]; s1 += g[k] * w; s0 += bta[k] * w; }
            s1 = wave_sum(s1); s0 = wave_sum(s0);
            if (lane == 0) { cst[c] = s1; cst[36 + c] = s0 + (c < 4 ? bg[c] : br[c - 4]); }
        }
    }
}

typedef float f32x2v __attribute__((ext_vector_type(2)));
__device__ __forceinline__ void ph_ln_router_f(const Params& p, int layer, unsigned char* lds) {
    const float* g = p.in[14] + layer * D_MODEL; const float* bta = p.in[15] + layer * D_MODEL;
    const float* tab = (const float*)(p.ws + WS_RTAB) + (size_t)layer * D_MODEL * 36;
    const float* cst = (const float*)(p.ws + WS_RCONST) + layer * 72;
    unsigned* cnt = (unsigned*)(p.ws + WS_CTL) + CW_CNT + layer * 32 * CNT_PAD;
    int* ltok = (int*)(p.ws + WS_LTOK); float* lw = (float*)(p.ws + WS_LW); int* epos = (int*)(p.ws + WS_EPOS);
    bf16_t* xb = (bf16_t*)(p.ws + WS_XB);
    const bf16_t* yb = (const bf16_t*)(p.ws + WS_HBUF + HB_YB);
    float* ltab = (float*)lds;
    int* part = (int*)(lds + 147456);
    float* stats = (float*)(lds + 147456 + 9728);
    const int tid = thr(), lane = tid & 63, wave = __builtin_amdgcn_readfirstlane(tid >> 6);
    __syncthreads();
    {
        float4 tv[9];
#pragma unroll 1
        for (int b9 = 0; b9 < 2; ++b9) {
#pragma unroll
            for (int j = 0; j < 9; ++j) tv[j] = ((const float4*)tab)[(b9 * 9 + j) * NTHREADS + tid];
#pragma unroll
            for (int j = 0; j < 9; ++j) ((float4*)ltab)[(b9 * 9 + j) * NTHREADS + tid] = tv[j];
        }
    }
    for (int it = blockIdx.x; it < T / 128; it += gridDim.x) {
        const int t0 = it * 128;
        __syncthreads();
        const float* cst_l = cst; const float* g_l = g; const float* b_l = bta;
        asm volatile("" : "+s"(cst_l), "+s"(g_l), "+s"(b_l));
#pragma unroll 1
        for (int h = 0; h < 2; ++h) {
            f32x16 dacc[2][2];
            float ssq[2] = {0.f, 0.f};
#pragma unroll
            for (int tb = 0; tb < 2; ++tb)
#pragma unroll
                for (int cb = 0; cb < 2; ++cb)
#pragma unroll
                    for (int r = 0; r < 16; ++r) dacc[tb][cb][r] = 0.f;
            {
                const int m = lane & 31, kh = lane >> 5;
                const bf16_t* yrow = yb + (size_t)(t0 + 64 * h + m) * D_MODEL + wave * 128 + 8 * kh;
                u32x4 bq[2][8];
#pragma unroll
                for (int tb = 0; tb < 2; ++tb)
#pragma unroll
                    for (int ks = 0; ks < 8; ++ks) bq[tb][ks] = *(const u32x4*)(yrow + (size_t)tb * 32 * D_MODEL + ks * 16);
                const float* wt = ltab + (wave * 128 + 8 * kh) * 36;
#pragma unroll
                for (int ks = 0; ks < 8; ++ks) {
                    bf16x8 bfr[2];
#pragma unroll
                    for (int tb = 0; tb < 2; ++tb) {
                        bfr[tb] = __builtin_bit_cast(bf16x8, bq[tb][ks]);
                        float yv[8]; unpack8(bq[tb][ks], yv);
#pragma unroll
                        for (int j = 0; j < 8; ++j) ssq[tb] = fmaf(yv[j], yv[j], ssq[tb]);
                    }
#pragma unroll
                    for (int cb = 0; cb < 2; ++cb) {
                        const int c = 32 * cb + m;
                        float x[8];
#pragma unroll
                        for (int j = 0; j < 8; ++j) { const float tv = wt[(ks * 16 + j) * 36 + (c < 36 ? c : 0)]; x[j] = c < 36 ? tv : (c == 36 ? 1.f : 0.f); }
                        unsigned hi[4], mi[4], lo[4];
#pragma unroll
                        for (int j2 = 0; j2 < 4; ++j2) {
                            const float x0 = x[2 * j2], x1 = x[2 * j2 + 1];
                            hi[j2] = pk2(x0, x1);
                            const float r0 = x0 - __uint_as_float(hi[j2] << 16), r1 = x1 - __uint_as_float(hi[j2] & 0xffff0000u);
                            mi[j2] = pk2(r0, r1);
                            const float q0 = r0 - __uint_as_float(mi[j2] << 16), q1 = r1 - __uint_as_float(mi[j2] & 0xffff0000u);
                            lo[j2] = pk2(q0, q1);
                        }
                        const u32x4 ah = {hi[0], hi[1], hi[2], hi[3]}, am = {mi[0], mi[1], mi[2], mi[3]}, al = {lo[0], lo[1], lo[2], lo[3]};
#pragma unroll
                        for (int tb = 0; tb < 2; ++tb) {
                            dacc[tb][cb] = MFMA32(__builtin_bit_cast(bf16x8, al), bfr[tb], dacc[tb][cb]);
                            dacc[tb][cb] = MFMA32(__builtin_bit_cast(bf16x8, am), bfr[tb], dacc[tb][cb]);
                            dacc[tb][cb] = MFMA32(__builtin_bit_cast(bf16x8, ah), bfr[tb], dacc[tb][cb]);
                        }
                    }
                }
            }
            __syncthreads();
            for (int i = tid; i < 38 * 64; i += NTHREADS) part[i] = 0;
            __syncthreads();
            {
                const int kh = lane >> 5;
#pragma unroll
                for (int tb = 0; tb < 2; ++tb) {
                    int* pw = part + 32 * tb + (lane & 31);
#pragma unroll
                    for (int r = 0; r < 16; ++r) atomicAdd(pw + ((r & 3) + 8 * (r >> 2) + 4 * kh) * 64, __float2int_rn(dacc[tb][0][r] * 4194304.f));
#pragma unroll
                    for (int r = 0; r < 4; ++r) { const int c = 32 + r + 4 * kh; if (c < 37) atomicAdd(pw + c * 64, __float2int_rn(dacc[tb][1][r] * 4194304.f)); }
                    atomicAdd(pw + 37 * 64, __float2int_rn(ssq[tb] * 65536.f));
                }
            }
            __syncthreads();
            if (wave == 0) {
                float v[38];
#pragma unroll
                for (int c = 0; c < 38; ++c) v[c] = (float)part[c * 64 + lane] * (c == 37 ? (1.f / 65536.f) : (1.f / 4194304.f));
                const float mu = v[36] * (1.f / D_MODEL), var = fmaxf(v[37] * (1.f / D_MODEL) - mu * mu, 0.f), rstd = rsqrtf(var + EPS);
                stats[(64 * h + lane) * 2] = mu; stats[(64 * h + lane) * 2 + 1] = rstd;
                float lg[36];
#pragma unroll
                for (int c = 0; c < 36; ++c) lg[c] = rstd * (v[c] - mu * cst_l[c]) + cst_l[36 + c];
                int gs = 0; float cm = lg[0];
                if (lg[1] > cm) { cm = lg[1]; gs = 1; }
                if (lg[2] > cm) { cm = lg[2]; gs = 2; }
                if (lg[3] > cm) { cm = lg[3]; gs = 3; }
                const float pg = 1.f / (expf(lg[0] - cm) + expf(lg[1] - cm) + expf(lg[2] - cm) + expf(lg[3] - cm));
                float f[8];
#pragma unroll
                for (int i = 0; i < 8; ++i) f[i] = gs == 0 ? lg[4 + i] : (gs == 1 ? lg[12 + i] : (gs == 2 ? lg[20 + i] : lg[28 + i]));
                int i1 = 0; float v1 = f[0];
#pragma unroll
                for (int i = 1; i < 8; ++i) if (f[i] > v1) { v1 = f[i]; i1 = i; }
                int i2 = -1; float v2 = -3.0e38f;
#pragma unroll
                for (int i = 0; i < 8; ++i) if (i != i1 && f[i] > v2) { v2 = f[i]; i2 = i; }
                const float e2 = expf(v2 - v1), w1 = pg / (1.f + e2), w2 = pg * e2 / (1.f + e2);
                const int t = t0 + 64 * h + lane, ea = gs * 8 + i1, eb = gs * 8 + i2;
                volatile LAS unsigned* lcnt = (volatile LAS unsigned*)(lds + 147456 + 9728 + 1024);
                if (lane < 32) lcnt[lane] = 0u;
                const unsigned la = __hip_atomic_fetch_add((LAS unsigned*)lcnt + ea, 1u, __ATOMIC_RELAXED, __HIP_MEMORY_SCOPE_WORKGROUP);
                const unsigned lb = __hip_atomic_fetch_add((LAS unsigned*)lcnt + eb, 1u, __ATOMIC_RELAXED, __HIP_MEMORY_SCOPE_WORKGROUP);
                if (lane < 32) { const unsigned c = lcnt[lane]; lcnt[32 + lane] = c ? atomicAdd(&cnt[lane * CNT_PAD], c) : 0u; }
                const unsigned pa = lcnt[32 + ea] + la, pb = lcnt[32 + eb] + lb;
                ltok[(size_t)ea * T + pa] = t; lw[(size_t)ea * T + pa] = w1;
                ltok[(size_t)eb * T + pb] = t; lw[(size_t)eb * T + pb] = w2;
                epos[t * 2 + 0] = (ea << 16) | (int)pa; epos[t * 2 + 1] = (eb << 16) | (int)pb;
            }
        }
        __syncthreads();
        {
            float gg[2][8], bb[2][8];
#pragma unroll
            for (int j = 0; j < 2; ++j) {
                const int k = j * 512 + lane * 8;
                const float4 g0 = *(const float4*)(g_l + k), g1 = *(const float4*)(g_l + k + 4), b0 = *(const float4*)(b_l + k), b1 = *(const float4*)(b_l + k + 4);
                gg[j][0] = g0.x; gg[j][1] = g0.y; gg[j][2] = g0.z; gg[j][3] = g0.w; gg[j][4] = g1.x; gg[j][5] = g1.y; gg[j][6] = g1.z; gg[j][7] = g1.w;
                bb[j][0] = b0.x; bb[j][1] = b0.y; bb[j][2] = b0.z; bb[j][3] = b0.w; bb[j][4] = b1.x; bb[j][5] = b1.y; bb[j][6] = b1.z; bb[j][7] = b1.w;
            }
#pragma unroll 1
            for (int r0 = 0; r0 < 16; r0 += 4) {
                u32x4 yq[4][2];
#pragma unroll
                for (int rr = 0; rr < 4; ++rr)
#pragma unroll
                    for (int j = 0; j < 2; ++j) yq[rr][j] = *(const u32x4*)(yb + (size_t)(t0 + wave * 16 + r0 + rr) * D_MODEL + j * 512 + lane * 8);
#pragma unroll
                for (int rr = 0; rr < 4; ++rr) {
                    const int tl = wave * 16 + r0 + rr;
                    const float mu = stats[tl * 2], rstd = stats[tl * 2 + 1];
#pragma unroll
                    for (int j = 0; j < 2; ++j) {
                        float v[8]; unpack8(yq[rr][j], v);
#pragma unroll
                        for (int e = 0; e < 8; ++e) v[e] = (v[e] - mu) * rstd * gg[j][e] + bb[j][e];
                        u32x4 o; o.x = pk2(v[0], v[1]); o.y = pk2(v[2], v[3]); o.z = pk2(v[4], v[5]); o.w = pk2(v[6], v[7]);
                        *(u32x4*)(xb + (size_t)(t0 + tl) * D_MODEL + j * 512 + lane * 8) = o;
                    }
                }
            }
        }
    }
}

__global__ void __launch_bounds__(NTHREADS, 2) fwd_megakernel(Params p) {
    extern __shared__ __attribute__((aligned(16))) unsigned char lds_raw[];
    float* smem = (float*)lds_raw;
    {
        volatile LAS unsigned* st0 = (volatile LAS unsigned*)(lds_raw + 163824);
        if (threadIdx.x < 2) st0[threadIdx.x] = 0u;
        __syncthreads();
    }
    (void)xcd_barrier_post((unsigned*)(p.ws + WS_CTL) + CW_BAR, (volatile LAS unsigned*)(lds_raw + 163824));
#define GRID_SYNC() do { XcdBarrier gb_; gb_.bar = (unsigned*)(p.ws + WS_CTL) + CW_BAR; gb_.x = xb_xcc_id(); gb_.st = (volatile LAS unsigned*)(lds_raw + 163824); xcd_barrier(gb_); } while (0)
#define RUN(mask, ...) do { __VA_ARGS__; if (PROBE & (mask)) { GRID_SYNC(); __VA_ARGS__; } } while (0)
    RUN(1, ph_prologue(p, lds_raw); ph_router_tables(p));
    GRID_SYNC();
    RUN(2, ph_inproj0_g8(p, lds_raw));
    GRID_SYNC();
    ph_mla_pre(p);
    GRID_SYNC();
    RUN(4, ph_mla_up_g8(p, lds_raw));
    GRID_SYNC();
    RUN(8, ph_attn0_f(p, lds_raw));
    GRID_SYNC();
    RUN(16, ph_outproj0_g8(p, lds_raw));
    GRID_SYNC();
    if (blockIdx.x & 1) { ph_cvt_moe(p, 0, lds_raw); ph_ln_router_f(p, 0, lds_raw); } else { ph_ln_router_f(p, 0, lds_raw); ph_cvt_moe(p, 0, lds_raw); }
    GRID_SYNC();
    RUN(64, ph_moe_up_g8(p, 0, lds_raw));
    GRID_SYNC();
    RUN(128, ph_moe_down_g8(p, 0, lds_raw));
    GRID_SYNC();
    ph_ffn_ln(p, 0, smem, false);
    GRID_SYNC();
    RUN(256, ph_inproj1_g8(p, lds_raw));
    GRID_SYNC();
    RUN(512, ph_dil_f<false>(p, lds_raw));
    GRID_SYNC();
    RUN(1024, ph_dil_f<true>(p, lds_raw));
    GRID_SYNC();
    ph_outproj1_g8(p, lds_raw);
    GRID_SYNC();
    if (blockIdx.x & 1) { ph_cvt_moe(p, 1, lds_raw); ph_ln_router_f(p, 1, lds_raw); } else { ph_ln_router_f(p, 1, lds_raw); ph_cvt_moe(p, 1, lds_raw); }
    GRID_SYNC();
    ph_moe_up_g8(p, 1, lds_raw);
    GRID_SYNC();
    ph_moe_down_g8(p, 1, lds_raw);
    GRID_SYNC();
    ph_ffn_ln(p, 1, smem, true);
}

constexpr size_t LDS_BYTES = 163840;

extern "C" void kernel_launch(void* const* d_in, const int* in_sizes, int n_in, void* d_out, int out_size, void* d_ws, size_t ws_size, hipStream_t stream) {
    static int grid_blocks = 0;
    if (grid_blocks == 0) {
        if (n_in != 25 || ws_size < WS_END) { fprintf(stderr, "kernel_launch: unexpected n_in %d / ws_size %zu (need %zu)\n", n_in, ws_size, (size_t)WS_END); grid_blocks = -1; return; }
        int dev = 0, cus = 0, per_cu = 0;
        hipGetDevice(&dev);
        hipDeviceGetAttribute(&cus, hipDeviceAttributeMultiprocessorCount, dev);
        hipFuncSetAttribute((const void*)fwd_megakernel, hipFuncAttributeMaxDynamicSharedMemorySize, (int)LDS_BYTES);
        hipOccupancyMaxActiveBlocksPerMultiprocessor(&per_cu, (const void*)fwd_megakernel, NTHREADS, LDS_BYTES);
        if (per_cu < 1) { fprintf(stderr, "kernel_launch: occupancy query gave %d\n", per_cu); grid_blocks = -1; return; }
        if (per_cu > 1) per_cu = 1;
        grid_blocks = cus * per_cu;
        fprintf(stderr, "kernel_launch: grid %d (cus %d x %d), ws %zu\n", grid_blocks, cus, per_cu, ws_size);
    }
    if (grid_blocks < 0) return;
    hipMemsetAsync((char*)d_ws + WS_CTL, 0, 1 * MiB, stream);
    Params p{};
    for (int i = 0; i < 25; ++i) p.in[i] = (const float*)d_in[i];
    p.out = (float*)d_out; p.ws = (unsigned char*)d_ws;
    void* args[] = {&p};
    hipError_t e = hipLaunchCooperativeKernel((const void*)fwd_megakernel, dim3(grid_blocks), dim3(NTHREADS), args, LDS_BYTES, stream);
    if (e != hipSuccess) fprintf(stderr, "cooperative launch failed: %s (grid %d)\n", hipGetErrorString(e), grid_blocks);
}
```
